# Optimizing an MI355X kernel written in HIP

```python
import jax, jax.numpy as jnp
from jax import lax
import numpy as np

D_MODEL = 1024
BATCH = 16
SEQ = 256
DEPTH = 1
DEC_BATCH = 4
DEC_SEQ = 4096
PAST_LEN = 512

GRID_W = 64
D_INNER = 2 * D_MODEL
D_SSD = D_INNER // 2
D_CM = D_INNER - D_SSD
SSD_HEAD_DIM = 64
N_SSD_HEADS = D_SSD // SSD_HEAD_DIM
N_SSD_GROUPS = 4
D_STATE = 128
D_CONV = 5
SSD_CHUNK = 128
CM_CHUNK = 128
N_CM_HEADS = 8
CM_HEAD_DIM = D_CM // N_CM_HEADS
D_FF = 4 * D_MODEL
N_MOD = 6
EPS = 1e-6
D_XBC = D_SSD + 2 * N_SSD_GROUPS * D_STATE
D_IN_PROJ = D_SSD + D_XBC + 2 * N_SSD_HEADS + 2 * D_CM
SPLITS = (D_SSD, D_SSD + D_XBC, D_SSD + D_XBC + 2 * N_SSD_HEADS, D_SSD + D_XBC + 2 * N_SSD_HEADS + D_CM)

kernel_name = "hybrid_ssd_chunkmlp_diffusion_step"


def rmsnorm(x, g):
    xf = x.astype(jnp.float32)
    y = xf * lax.rsqrt(jnp.mean(xf * xf, axis=-1, keepdims=True) + EPS)
    return (y * g.astype(jnp.float32)).astype(x.dtype)


def layernorm(x, g, b):
    xf = x.astype(jnp.float32)
    mu = jnp.mean(xf, axis=-1, keepdims=True)
    var = jnp.mean(jnp.square(xf - mu), axis=-1, keepdims=True)
    y = (xf - mu) * lax.rsqrt(var + EPS)
    return (y * g.astype(jnp.float32) + b.astype(jnp.float32)).astype(x.dtype)


def sincos_2d(L, dtype):
    rows = L // GRID_W
    r, col = jnp.meshgrid(jnp.arange(rows, dtype=jnp.float32), jnp.arange(GRID_W, dtype=jnp.float32), indexing='ij')
    r, col = r.reshape(L), col.reshape(L)
    nf = D_MODEL // 4
    omega = 1.0 / (10000.0 ** (jnp.arange(nf, dtype=jnp.float32) / nf))
    ar = r[:, None] * omega
    ac = col[:, None] * omega
    return jnp.concatenate([jnp.sin(ar), jnp.cos(ar), jnp.sin(ac), jnp.cos(ac)], axis=-1).astype(dtype)


def centred_dwconv(x, w, b):
    pad = D_CONV // 2
    L = x.shape[1]
    xp = jnp.pad(x, ((0, 0), (pad, pad), (0, 0)))
    out = b
    for k in range(D_CONV):
        out = out + xp[:, k:k + L] * w[k]
    return out


def ssd_chunked(x, dt, A, Bm, Cm, h0):
    out_dtype = x.dtype
    b, L, H, P = x.shape
    G, N = Bm.shape[2], Bm.shape[3]
    hg = H // G
    Q = SSD_CHUNK
    nc = L // Q
    xc = x.astype(jnp.float32).reshape(b, nc, Q, G, hg, P)
    dtc = dt.reshape(b, nc, Q, G, hg)
    Bc = Bm.astype(jnp.float32).reshape(b, nc, Q, G, N)
    Cc = Cm.astype(jnp.float32).reshape(b, nc, Q, G, N)
    a_cum = jnp.cumsum(dtc * A.reshape(G, hg), axis=2)
    xdt = xc * dtc[..., None]
    seg = a_cum[:, :, :, None] - a_cum[:, :, None, :]
    mask = jnp.tril(jnp.ones((Q, Q), dtype=bool))[None, None, :, :, None, None]
    decay = jnp.exp(jnp.where(mask, seg, -jnp.inf))
    cb = jnp.einsum('bcign,bcjgn->bcijg', Cc, Bc)
    y_diag = jnp.einsum('bcijgh,bcjghp->bcighp', cb[..., None] * decay, xdt)
    decay_to_end = jnp.exp(a_cum[:, :, -1:] - a_cum)
    states = jnp.einsum('bcjgn,bcjghp->bcghpn', Bc, decay_to_end[..., None] * xdt)
    chunk_decay = jnp.exp(a_cum[:, :, -1])

    def step(h, inp):
        s, dA = inp
        return h * dA[..., None, None] + s, h

    h_init = h0.astype(jnp.float32).reshape(b, G, hg, P, N)
    h_final, h_starts = lax.scan(step, h_init, (jnp.moveaxis(states, 1, 0), jnp.moveaxis(chunk_decay, 1, 0)))
    h_starts = jnp.moveaxis(h_starts, 0, 1)
    y_off = jnp.einsum('bcign,bcghpn->bcighp', Cc, h_starts) * jnp.exp(a_cum)[..., None]
    y = (y_diag + y_off).reshape(b, L, H, P)
    return y.astype(out_dtype), h_final.reshape(b, H, P, N).astype(out_dtype)


def ssd_mixer(z, xbc, dt_raw, conv_w, conv_b, dt_bias, A_log, d_skip, norm_g, h0):
    b, L, _ = z.shape
    xbc = jax.nn.silu(centred_dwconv(xbc, conv_w, conv_b))
    xs, Bm, Cm = jnp.split(xbc, (D_SSD, D_SSD + N_SSD_GROUPS * D_STATE), axis=-1)
    xh = xs.reshape(b, L, N_SSD_HEADS, SSD_HEAD_DIM)
    Bm = Bm.reshape(b, L, N_SSD_GROUPS, D_STATE)
    Cm = Cm.reshape(b, L, N_SSD_GROUPS, D_STATE)
    dt = jax.nn.softplus(dt_raw.astype(jnp.float32) + dt_bias.astype(jnp.float32))
    A = -jnp.exp(A_log.astype(jnp.float32))
    flip = lambda t: jnp.flip(t, axis=1)
    y_f, hf_f = ssd_chunked(xh, dt[:, :, 0], A[0], Bm, Cm, h0[:, 0])
    y_b, hf_b = ssd_chunked(flip(xh), flip(dt[:, :, 1]), A[1], flip(Bm), flip(Cm), h0[:, 1])
    y = y_f + flip(y_b) + xh * d_skip[:, None]
    y = y.reshape(b, L, D_SSD)
    out = rmsnorm(y * jax.nn.silu(z), norm_g)
    return out, jnp.stack([hf_f, hf_b], axis=1)


def chunk_mlp(u, v, ln_g, ln_b, w_s, b_s):
    u = jax.nn.gelu(u)
    v = layernorm(jax.nn.gelu(v), ln_g, ln_b)
    b, L, _ = v.shape
    nc = L // CM_CHUNK
    vc = v.reshape(b, nc, CM_CHUNK, N_CM_HEADS, CM_HEAD_DIM)
    mixed = jnp.einsum('hts,bcshd->bcthd', w_s, vc) + b_s.T[:, :, None]
    return u * mixed.reshape(b, L, D_CM)


def trunk_layer(x, cond, h0, w_ada, b_ada, norm1_g, w_in, conv_w, conv_b, dt_bias, A_log, d_skip,
                ssd_norm_g, cm_ln_g, cm_ln_b, cm_w_s, cm_b_s, w_out, norm2_g, w_ff1, w_ff2):
    b, L, _ = x.shape
    mod = jax.nn.silu(cond) @ w_ada + b_ada
    sh1, sc1, g1, sh2, sc2, g2 = [m[:, None, :] for m in jnp.split(mod, N_MOD, axis=-1)]
    h = rmsnorm(x, norm1_g) * (1 + sc1) + sh1
    proj = h @ w_in
    z, xbc, dt_raw, u, v = jnp.split(proj, SPLITS, axis=-1)
    y_ssd, h_fin = ssd_mixer(z, xbc, dt_raw.reshape(b, L, 2, N_SSD_HEADS), conv_w, conv_b,
                             dt_bias, A_log, d_skip, ssd_norm_g, h0)
    y_cm = chunk_mlp(u, v, cm_ln_g, cm_ln_b, cm_w_s, cm_b_s)
    x = x + g1 * (jnp.concatenate([y_ssd, y_cm], axis=-1) @ w_out)
    h = rmsnorm(x, norm2_g) * (1 + sc2) + sh2
    x = x + g2 * (jnp.square(jax.nn.relu(h @ w_ff1)) @ w_ff2)
    return x, h_fin


def setup_inputs(seed: int = 0) -> dict:
    key = jax.random.key(seed)
    ks = jax.random.split(key, 32)
    nrm = lambda k, shape, s: jax.random.normal(k, shape, jnp.float32) * s
    dt0 = jnp.exp(jax.random.uniform(ks[10], (DEPTH, 2, N_SSD_HEADS), jnp.float32,
                                     np.log(1e-3).astype(np.float32), np.log(1e-1).astype(np.float32)))
    return {
        "x_prompt": nrm(ks[0], (BATCH, SEQ, D_MODEL), 1.0),
        "x_sample": nrm(ks[1], (DEC_BATCH, DEC_SEQ, D_MODEL), 1.0),
        "state_ssd": nrm(ks[2], (DEC_BATCH, DEPTH, 2, N_SSD_HEADS, SSD_HEAD_DIM, D_STATE), 0.1),
        "c": nrm(ks[3], (DEC_BATCH, D_MODEL), 1.0),
        "c_ctx": nrm(ks[4], (D_MODEL,), 1.0),
        "w_ada": nrm(ks[5], (DEPTH, D_MODEL, N_MOD * D_MODEL), D_MODEL ** -0.5),
        "b_ada": nrm(ks[6], (DEPTH, N_MOD * D_MODEL), 0.02),
        "norm1_g": 1.0 + nrm(ks[7], (DEPTH, D_MODEL), 0.02),
        "w_in": nrm(ks[8], (DEPTH, D_MODEL, D_IN_PROJ), D_MODEL ** -0.5),
        "conv_w": nrm(ks[9], (DEPTH, D_CONV, D_XBC), D_CONV ** -0.5),
        "conv_b": nrm(ks[11], (DEPTH, D_XBC), 0.02),
        "dt_bias": dt0 + jnp.log(-jnp.expm1(-dt0)),
        "A_log": jnp.log(jax.random.uniform(ks[12], (DEPTH, 2, N_SSD_HEADS), jnp.float32, 1.0, 16.0)),
        "d_skip": 1.0 + nrm(ks[13], (DEPTH, N_SSD_HEADS), 0.02),
        "ssd_norm_g": 1.0 + nrm(ks[14], (DEPTH, D_SSD), 0.02),
        "cm_ln_g": 1.0 + nrm(ks[15], (DEPTH, D_CM), 0.02),
        "cm_ln_b": nrm(ks[16], (DEPTH, D_CM), 0.02),
        "cm_w_s": nrm(ks[17], (DEPTH, N_CM_HEADS, CM_CHUNK, CM_CHUNK), CM_CHUNK ** -0.5),
        "cm_b_s": 1.0 + nrm(ks[18], (DEPTH, N_CM_HEADS, CM_CHUNK), 0.02),
        "w_out": nrm(ks[19], (DEPTH, D_INNER, D_MODEL), D_INNER ** -0.5),
        "norm2_g": 1.0 + nrm(ks[20], (DEPTH, D_MODEL), 0.02),
        "w_ff1": nrm(ks[21], (DEPTH, D_MODEL, D_FF), D_MODEL ** -0.5),
        "w_ff2": nrm(ks[22], (DEPTH, D_FF, D_MODEL), D_FF ** -0.5),
        "final_norm_g": 1.0 + nrm(ks[23], (D_MODEL,), 0.02),
    }


def reference(x_prompt, x_sample, state_ssd, c, c_ctx, w_ada, b_ada, norm1_g, w_in, conv_w, conv_b,
              dt_bias, A_log, d_skip, ssd_norm_g, cm_ln_g, cm_ln_b, cm_w_s, cm_b_s, w_out, norm2_g,
              w_ff1, w_ff2, final_norm_g):
    layer_params = (w_ada, b_ada, norm1_g, w_in, conv_w, conv_b, dt_bias, A_log, d_skip, ssd_norm_g,
                    cm_ln_g, cm_ln_b, cm_w_s, cm_b_s, w_out, norm2_g, w_ff1, w_ff2)
    bp = x_prompt.shape[0]
    xp = x_prompt
    cond_ctx = jnp.broadcast_to(c_ctx, (bp, D_MODEL))
    h0_ctx = jnp.zeros((bp, 2, N_SSD_HEADS, SSD_HEAD_DIM, D_STATE), x_prompt.dtype)
    ctx_states = []
    for l in range(DEPTH):
        xp, st = trunk_layer(xp, cond_ctx, h0_ctx, *[w[l] for w in layer_params])
        ctx_states.append(st)
    y_prompt = rmsnorm(xp, final_norm_g)
    new_state_ssd = jnp.stack(ctx_states, axis=1)
    xs = x_sample + sincos_2d(x_sample.shape[1], x_sample.dtype)[None]
    for l in range(DEPTH):
        xs, _ = trunk_layer(xs, c, state_ssd[:, l], *[w[l] for w in layer_params])
    y_sample = rmsnorm(xs, final_norm_g)
    return (y_prompt, y_sample, new_state_ssd)
```

```cpp
#include <hip/hip_runtime.h>
#include <hip/hip_cooperative_groups.h>
#include <cstdio>
namespace cg = cooperative_groups;

#define LAS __attribute__((address_space(3)))
#define DI __device__ __forceinline__
typedef unsigned short bf16_t;
typedef short bf16x8 __attribute__((ext_vector_type(8)));
typedef short s16x4 __attribute__((ext_vector_type(4)));
typedef float f32x4 __attribute__((ext_vector_type(4)));
typedef float f32x2 __attribute__((ext_vector_type(2)));
typedef unsigned u32x4 __attribute__((ext_vector_type(4)));
typedef unsigned u32x2 __attribute__((ext_vector_type(2)));

constexpr int MT = 20480, NPR = 4096, DM = 1024;
constexpr int NIN = 5376;
constexpr float EPSF = 1e-6f;
constexpr float LOG2E = 1.4426950408889634f;

constexpr size_t OFF_WFF2 = 0;
constexpr size_t OFF_WSB = OFF_WFF2 + (size_t)4096 * 1024 * 2;
constexpr size_t OFF_MOD = OFF_WSB + (size_t)8 * 128 * 128 * 2;
constexpr size_t OFF_PE = OFF_MOD + (size_t)5 * 6144 * 4;
constexpr size_t OFF_SSQ = OFF_PE + (size_t)64 * 512 * 4;
constexpr size_t OFF_BAR = OFF_SSQ + (size_t)MT * 4 * 4;
constexpr size_t OFF_HB = OFF_BAR + 16384;
constexpr size_t OFF_F = OFF_HB + (size_t)MT * 1024 * 2;
constexpr size_t OFF_ZG = OFF_HB + (size_t)MT * 2048 * 2;
constexpr size_t OFF_U = OFF_ZG + (size_t)MT * 1024 * 2;
constexpr size_t OFF_V = OFF_U + (size_t)MT * 1024 * 2;
constexpr size_t OFF_WIN = OFF_V + (size_t)MT * 1024 * 2;
constexpr size_t OFF_WOUT = OFF_WIN + (size_t)NIN * 1024 * 2;
constexpr size_t OFF_WFF1 = OFF_WOUT + (size_t)1024 * 2048 * 2;
constexpr size_t OFF_DT = OFF_WFF1 + (size_t)4096 * 1024 * 2;
constexpr size_t OFF_DTA = OFF_DT + (size_t)MT * 32 * 4;
constexpr size_t WS_END0 = OFF_DTA + (size_t)MT * 32 * 2 * 4;
constexpr size_t OFF_P5A = OFF_WIN;
constexpr size_t OFF_P5B = OFF_HB;
constexpr size_t OFF_S = OFF_HB;
constexpr size_t OFF_P3A = OFF_HB;
constexpr size_t OFF_P3B = OFF_F;
constexpr size_t OFF_LNP = (OFF_P5A + (size_t)MT * 1024 * 2) > WS_END0 ? (OFF_P5A + (size_t)MT * 1024 * 2) : WS_END0;
constexpr size_t WS_END = OFF_LNP + (size_t)MT * 16 * 2 * 4;
static_assert(WS_END <= (size_t)256 * 1024 * 1024, "workspace too large");
static_assert(OFF_F + (size_t)MT * 4096 * 2 == OFF_WIN, "F overlay");
static_assert(OFF_HB % 256 == 0 && OFF_WIN % 256 == 0, "align");

constexpr int LDS_WORK = 151552;
constexpr int LDS_BYTES = LDS_WORK + 16;

struct Params {
    const float* in[24];
    float* out;
    unsigned char* ws;
};

DI unsigned pk2(float lo, float hi) { unsigned r; asm volatile("v_cvt_pk_bf16_f32 %0, %1, %2" : "=v"(r) : "v"(lo), "v"(hi)); return r; }
DI float bflo(unsigned u) { return __uint_as_float(u << 16); }
DI float bfhi(unsigned u) { return __uint_as_float(u & 0xffff0000u); }
DI int otid() { int t = threadIdx.x; asm volatile("" : "+v"(t)); return t; }
DI float wave_sum(float v) {
#pragma unroll
    for (int o = 1; o < 64; o <<= 1) v += __shfl_xor(v, o);
    return v;
}
DI float ex2(float x) { return __builtin_amdgcn_exp2f(x); }
DI float silu_f(float x) { return x * __builtin_amdgcn_rcpf(1.0f + ex2(-x * LOG2E)); }
DI float gelu_f(float x) {
    const float u = x * (1.0f + 0.044715f * x * x) * (2.0f * 0.7978845608028654f * LOG2E);
    return x * __builtin_amdgcn_rcpf(1.0f + ex2(-u));
}
DI f32x2 silu2(f32x2 v) { const f32x2 t = v * (-LOG2E); f32x2 d; d.x = ex2(t.x); d.y = ex2(t.y); d = d + 1.0f; f32x2 r; r.x = __builtin_amdgcn_rcpf(d.x); r.y = __builtin_amdgcn_rcpf(d.y); return v * r; }
DI f32x2 gelu2(f32x2 v) {
    constexpr float C = 2.0f * 0.7978845608028654f * LOG2E;
    const f32x2 w = __builtin_elementwise_fma(v * v, (f32x2){-0.044715f * C, -0.044715f * C}, (f32x2){-C, -C});
    const f32x2 t = v * w; f32x2 d; d.x = ex2(t.x); d.y = ex2(t.y); d = d + 1.0f; f32x2 r; r.x = __builtin_amdgcn_rcpf(d.x); r.y = __builtin_amdgcn_rcpf(d.y); return v * r;
}
DI const float* xrow_ptr(const Params& p, int tok) { return tok < NPR ? p.in[0] + (size_t)tok * DM : p.in[1] + (size_t)(tok - NPR) * DM; }
DI int cond_of(int tok) { return tok < NPR ? 0 : 1 + ((tok - NPR) >> 12); }
DI s16x4 trrd(LAS unsigned char* a) { return __builtin_amdgcn_ds_read_tr16_b64_v4i16((LAS s16x4*)a); }
DI bf16x8 cat8(s16x4 a, s16x4 b) { bf16x8 r = {a[0], a[1], a[2], a[3], b[0], b[1], b[2], b[3]}; return r; }
DI bf16x8 u4_as_bf8(u32x4 v) { return __builtin_bit_cast(bf16x8, v); }


#define XB_TMO      128
#define XB_XCNT(j)  (256  + 64 * (j))
#define XB_XSUB(j)  (1280 + 64 * (j))
#define XB_XGEN(j)  (2304 + 64 * (j))
#define XB_TOP      3328
#define XB_TOPGEN   3392
#define XCD_BAR_WORDS 3456
#define XB_SPIN_CAP (1u << 20)
DI unsigned xb_ld(unsigned* p)              { return __hip_atomic_load(p, __ATOMIC_RELAXED, __HIP_MEMORY_SCOPE_AGENT); }
DI unsigned xb_add(unsigned* p, unsigned v) { return __hip_atomic_fetch_add(p, v, __ATOMIC_RELAXED, __HIP_MEMORY_SCOPE_AGENT); }
DI unsigned xb_xcc_id() { return (unsigned)__builtin_amdgcn_s_getreg((3 << 11) | 20) & 0xFu; }
#define XB_SPIN(cond, bar) do { unsigned _sp = 0; while (cond) { __builtin_amdgcn_s_sleep(1); \
    if ((++_sp & 255u) == 0u) { if (xb_ld(&(bar)[XB_TMO])) break; if (_sp > XB_SPIN_CAP) { atomicAdd(&(bar)[XB_TMO], 1u); break; } } } } while (0)
struct XcdBarrier { unsigned* bar; unsigned x; volatile LAS unsigned* st; };
DI XcdBarrier xcd_barrier_post(unsigned* bar, volatile LAS unsigned* st) {
    XcdBarrier b; b.bar = bar; b.x = xb_xcc_id(); b.st = st;
    if (threadIdx.x == 0) (void)xb_add(&bar[XB_XCNT(b.x)], 1u);
    return b;
}
DI void xcd_barrier_complete(unsigned* bar, unsigned x, unsigned& nloc, unsigned& nx) {
    const unsigned G = gridDim.x * gridDim.y * gridDim.z;
    unsigned sum, cnt, mine, sp = 0u;
    for (;;) {
        sum = 0u; cnt = 0u; mine = 0u;
#pragma unroll
        for (unsigned j = 0; j < 16; ++j) { const unsigned c = xb_ld(&bar[XB_XCNT(j)]); sum += c; cnt += (c > 0u) ? 1u : 0u; mine = (j == x) ? c : mine; }
        if (sum == G) break;
        __builtin_amdgcn_s_sleep(1);
        if ((++sp & 255u) == 0u) { if (xb_ld(&bar[XB_TMO])) break; if (sp > XB_SPIN_CAP) { atomicAdd(&bar[XB_TMO], 1u); break; } }
    }
    nloc = mine > 0u ? mine : 1u; nx = cnt > 0u ? cnt : 1u;
}
DI void xcd_barrier(const XcdBarrier& b) {
    asm volatile("s_waitcnt vmcnt(0)" ::: "memory");
    __syncthreads();
    if (threadIdx.x == 0) {
        unsigned* bar = b.bar;
        __builtin_amdgcn_s_waitcnt(0);
        unsigned nloc = b.st[0], nx = b.st[1];
        if (nloc == 0u) { xcd_barrier_complete(bar, b.x, nloc, nx); b.st[0] = nloc; b.st[1] = nx; }
        const unsigned old = xb_add(&bar[XB_XSUB(b.x)], 1u);
        const unsigned gen = old / nloc;
        if (old + 1u == (gen + 1u) * nloc) {
            __builtin_amdgcn_fence(__ATOMIC_RELEASE, "agent");
            asm volatile("s_waitcnt vmcnt(0)" ::: "memory");
            const unsigned og = xb_add(&bar[XB_TOP], 1u);
            const unsigned tg = og / nx;
            if (og + 1u == (tg + 1u) * nx) xb_add(&bar[XB_TOPGEN], 1u);
            else XB_SPIN(xb_ld(&bar[XB_TOPGEN]) == tg, bar);
            __builtin_amdgcn_fence(__ATOMIC_ACQUIRE, "agent");
            xb_add(&bar[XB_XGEN(b.x)], 1u);
            asm volatile("s_waitcnt vmcnt(0)" ::: "memory");
        } else {
            XB_SPIN(xb_ld(&bar[XB_XGEN(b.x)]) == gen, bar);
            __builtin_amdgcn_fence(__ATOMIC_ACQUIRE, "agent");
            asm volatile("s_waitcnt vmcnt(0)" ::: "memory");
        }
    }
    __syncthreads();
}

namespace pg8 {
constexpr int BM = 256, BK = 64, HALF = 128, HTB = HALF * BK * 2, STAGE_BYTES = 8 * HTB, NXCD = 8, WGM = 8;
DI int lds_byte(int r, int c) { const int st = (r >> 4) * 2 + (c >> 5), rr = r & 15, cc = c & 31, ob = rr * 64 + cc * 2; return st * 1024 + (ob ^ (((ob >> 9) & 1) << 5)); }
DI void stage_rc(int b, int& R, int& C) { const int st = b / 1024, sb = b % 1024, swz = sb ^ (((sb >> 9) & 1) << 5); R = (st >> 1) * 16 + swz / 64; C = (st & 1) * 32 + (swz % 64) / 2; }
DI int perm32(int rho) { const int n = rho >> 4, i = rho & 15; return 8 * (i >> 2) + 4 * n + (i & 3); }
struct Unit { int pm, pn, kh, nt; size_t koffA, koffB; };
struct Gemm { const bf16_t* A; const bf16_t* A2; const bf16_t* Bt; int lda, ldb, nt, ksplit, nnr; size_t koffA, koffB; const float* ssq; };
struct StaticOrder {
    static constexpr bool CUSTOM = false;
    int nM, nN, nwg, G, c;
    DI void init(int M, int N, int G_, int c_) { nM = M / BM; nN = N / BM; nwg = nM * nN; G = G_; c = c_; }
    DI bool next(int i, Unit& u) const {
        const long L = (long)i * G + c; if (L >= nwg) return false;
        int wgid = (int)L; { const int q = nwg / NXCD, r = nwg % NXCD, xcd = wgid % NXCD, off = wgid / NXCD; wgid = (xcd < r ? xcd * (q + 1) : r * (q + 1) + (xcd - r) * q) + off; }
        const int nig = WGM * nN, gid = wgid / nig, fm = gid * WGM, gsz = (nM - fm) < WGM ? (nM - fm) : WGM;
        u.pm = fm + ((wgid % nig) % gsz); u.pn = (wgid % nig) / gsz; return true;
    }
};

struct HybridOrder5 {
    static constexpr bool CUSTOM = true;
    int G, c;
    DI bool next(int i, Unit& u) const {
        const int id = i * G + c; if (id >= 512) return false;
        const int x = id & 7, j = (id & 255) >> 3;
        if (id < 256) { u.pm = 8 * x + (j & 7); u.pn = j >> 3; u.kh = 0; u.nt = 64; u.koffA = 0; u.koffB = 0; }
        else { const int kq = j >> 3; u.pm = 64 + 2 * x + (j & 1); u.pn = (j >> 1) & 3; u.kh = kq; u.nt = 16; u.koffA = (size_t)kq * 1024 * 2; u.koffB = (size_t)kq * 1024 * 2; }
        return true;
    }
};
struct HybridOrder3 {
    static constexpr bool CUSTOM = true;
    int G, c; size_t uoff;
    DI bool next(int i, Unit& u) const {
        const int id = i * G + c; if (id >= 512) return false;
        const int x = id & 7, j = (id & 255) >> 3;
        if (id < 256) { u.pm = 8 * x + (j & 7); u.pn = j >> 3; u.kh = 0; u.nt = 32; u.koffA = 0; u.koffB = 0; }
        else { const int kq = j >> 3; u.pm = 64 + 2 * x + (j & 1); u.pn = (j >> 1) & 3; u.kh = kq; u.nt = 8; u.koffA = (kq >= 2 ? uoff : (size_t)0) + (size_t)(kq & 1) * 512 * 2; u.koffB = (size_t)kq * 512 * 2; }
        return true;
    }
};

template <class Epi, class Sched>
DI void gemm_phase(LAS unsigned char* lds, const Gemm g, const Sched& S, const Epi& E) {
    int tid_ = threadIdx.x; asm volatile("" : "+v"(tid_));
    const int tid = tid_, wid = __builtin_amdgcn_readfirstlane(tid >> 6), lane = tid & 63, wr = wid >> 2, wc = wid & 3, fr = lane & 15, fq = lane >> 4;
    const int K = g.ldb, lda = g.lda, ksp = g.ksplit;
    unsigned voffA[2], voffB[2];
#pragma unroll
    for (int i = 0; i < 2; ++i) { int R, C; stage_rc(tid * 16 + i * 8192, R, C); const int Rb = Epi::PERM ? ((R & ~31) + perm32(R & 31)) : R;
        voffA[i] = (unsigned)(R * lda + C) * 2u; voffB[i] = (unsigned)(Rb * K + C) * 2u; }
    const size_t kstep = (size_t)(BK * 2);
    const size_t hstepA = (size_t)HALF * lda * 2, hstepB = (size_t)HALF * K * 2;
    const size_t tstepA = 2 * hstepA, tstepB = 2 * hstepB;
    const unsigned ldsw = (unsigned)wid * 1024u;
    const int aoff = lds_byte(wr * 64 + fr, fq * 8), boff = lds_byte(wc * 32 + fr, fq * 8);
#define PG8_SA(b, h) (((b) * 2 + (h)) * HTB)
#define PG8_SB(b, h) ((4 + (b) * 2 + (h)) * HTB)
#define PG8_STAGE(bufoff, gbase, voff) do { _Pragma("unroll") for (int _i = 0; _i < 2; ++_i) \
        __builtin_amdgcn_global_load_lds((const unsigned*)((const char*)(gbase) + (voff)[_i]), (LAS unsigned*)(lds + (bufoff) + ldsw + _i * 8192), 16, 0, 0); } while (0)
#define PG8_LDA(dst, b, h) do { _Pragma("unroll") for (int m = 0; m < 4; ++m) _Pragma("unroll") for (int k = 0; k < 2; ++k) dst[m][k] = *(const LAS bf16x8*)(lds + PG8_SA(b, h) + aoff + m * 2048 + k * 1024); } while (0)
#define PG8_LDB(dst, b, h) do { _Pragma("unroll") for (int n = 0; n < 2; ++n) _Pragma("unroll") for (int k = 0; k < 2; ++k) dst[n][k] = *(const LAS bf16x8*)(lds + PG8_SB(b, h) + boff + n * 2048 + k * 1024); } while (0)
#define PG8_MMA(ai, bj, At, Bt) do { __builtin_amdgcn_s_setprio(1); _Pragma("unroll") for (int m = 0; m < 4; ++m) _Pragma("unroll") for (int n = 0; n < 2; ++n) _Pragma("unroll") for (int k = 0; k < 2; ++k) \
        acc[ai][bj][m][n] = __builtin_amdgcn_mfma_f32_16x16x32_bf16(Bt[n][k], At[m][k], acc[ai][bj][m][n], 0, 0, 0); __builtin_amdgcn_s_setprio(0); } while (0)
#define PG8_WAIT_V(n) asm volatile("s_waitcnt vmcnt(" #n ")" ::: "memory")
#define PG8_WAIT_L(n) asm volatile("s_waitcnt lgkmcnt(" #n ")" ::: "memory")
#define PG8_BAR __builtin_amdgcn_s_barrier()
#define PG8_SCHED __builtin_amdgcn_sched_barrier(0)
#define PG8_APTR(b1, b2, t) ((t) < ksp ? (b1) + (size_t)(t) * kstep : (b2) + (size_t)((t) - ksp) * kstep)
    Unit cur, nxt; int ui = 0;
    if (!S.next(0, cur)) return;
    if constexpr (!Sched::CUSTOM) { cur.kh = cur.pn / g.nnr; cur.pn -= cur.kh * g.nnr; cur.nt = g.nt; cur.koffA = (size_t)cur.kh * g.koffA; cur.koffB = (size_t)cur.kh * g.koffB; }
    int nt = cur.nt;
    f32x4 acc[2][2][4][2];
#pragma unroll
    for (int a = 0; a < 2; ++a)
#pragma unroll
        for (int b = 0; b < 2; ++b)
#pragma unroll
            for (int m = 0; m < 4; ++m)
#pragma unroll
                for (int n = 0; n < 2; ++n) acc[a][b][m][n] = (f32x4){0.f, 0.f, 0.f, 0.f};
    bf16x8 At[4][2], B0[2][2], B1[2][2];
    const char* cA = (const char*)g.A + (size_t)cur.pm * tstepA + cur.koffA; const char* cA2 = (const char*)g.A2 + (size_t)cur.pm * tstepA;
    const char* cB = (const char*)g.Bt + (size_t)cur.pn * tstepB + cur.koffB;
    PG8_STAGE(PG8_SB(0, 0), cB, voffB); PG8_STAGE(PG8_SA(0, 0), cA, voffA); PG8_STAGE(PG8_SB(0, 1), cB + hstepB, voffB); PG8_STAGE(PG8_SA(0, 1), cA + hstepA, voffA);
    if (wr == 1) PG8_BAR;
    PG8_WAIT_V(4); PG8_BAR;
    PG8_STAGE(PG8_SB(1, 0), cB + kstep, voffB); PG8_STAGE(PG8_SA(1, 0), cA + kstep, voffA); PG8_STAGE(PG8_SB(1, 1), cB + hstepB + kstep, voffB);
    PG8_WAIT_V(6); PG8_BAR;
    for (;;) {
        const bool has_next = S.next(ui + 1, nxt);
        if constexpr (!Sched::CUSTOM) { if (has_next) { nxt.kh = nxt.pn / g.nnr; nxt.pn -= nxt.kh * g.nnr; nxt.nt = g.nt; nxt.koffA = (size_t)nxt.kh * g.koffA; nxt.koffB = (size_t)nxt.kh * g.koffB; } }
        const char* nA = has_next ? (const char*)g.A + (size_t)nxt.pm * tstepA + nxt.koffA : cA; const char* nB = has_next ? (const char*)g.Bt + (size_t)nxt.pn * tstepB + nxt.koffB : cB;
        for (int t = 0; t < nt; t += 2) {
            const bool last = (t == nt - 2);
            const char* a1 = PG8_APTR(cA, cA2, t + 1);
            const char* a2 = last ? nA : PG8_APTR(cA, cA2, t + 2); const char* b2 = last ? nB : cB + (size_t)(t + 2) * kstep;
            const char* a3 = a2 + kstep; const char* b3 = b2 + kstep;
            if constexpr (Epi::MIDSCALE) {
                if (t == ksp) {
#pragma unroll
                    for (int ai = 0; ai < 2; ++ai)
#pragma unroll
                        for (int m = 0; m < 4; ++m) {
                            const int row = cur.pm * BM + ai * HALF + wr * 64 + m * 16 + fr;
                            const f32x4 s4 = *(const f32x4*)(g.ssq + (size_t)row * 4);
                            const float rs = __builtin_amdgcn_rsqf(((s4[0] + s4[1]) + (s4[2] + s4[3])) * (1.0f / 1024.0f) + EPSF);
#pragma unroll
                            for (int bj = 0; bj < 2; ++bj)
#pragma unroll
                                for (int n = 0; n < 2; ++n) acc[ai][bj][m][n] *= rs;
                            if (m & 1) asm volatile("" ::: "memory");
                        }
                }
            }
            PG8_LDB(B0, 0, 0); PG8_SCHED; PG8_LDA(At, 0, 0); PG8_STAGE(PG8_SA(1, 1), a1 + hstepA, voffA);
            PG8_WAIT_L(8); PG8_BAR; PG8_WAIT_L(0); PG8_MMA(0, 0, At, B0); PG8_BAR; PG8_SCHED;
            PG8_LDB(B1, 0, 1); PG8_STAGE(PG8_SB(0, 0), b2, voffB);
            PG8_BAR; PG8_WAIT_L(0); PG8_MMA(0, 1, At, B1); PG8_BAR;
            PG8_LDA(At, 0, 1); PG8_STAGE(PG8_SA(0, 0), a2, voffA);
            PG8_BAR; PG8_WAIT_L(0); PG8_MMA(1, 0, At, B0); PG8_BAR; PG8_SCHED;
            PG8_STAGE(PG8_SB(0, 1), b2 + hstepB, voffB);
            PG8_WAIT_V(6); PG8_BAR; PG8_MMA(1, 1, At, B1); PG8_BAR;
            PG8_LDB(B0, 1, 0); PG8_SCHED; PG8_LDA(At, 1, 0); PG8_STAGE(PG8_SA(0, 1), a2 + hstepA, voffA);
            PG8_WAIT_L(8); PG8_BAR; PG8_WAIT_L(0); PG8_MMA(0, 0, At, B0); PG8_BAR; PG8_SCHED;
            PG8_LDB(B1, 1, 1); PG8_STAGE(PG8_SB(1, 0), b3, voffB);
            PG8_BAR; PG8_WAIT_L(0); PG8_MMA(0, 1, At, B1); PG8_BAR;
            PG8_LDA(At, 1, 1); PG8_STAGE(PG8_SA(1, 0), a3, voffA);
            PG8_BAR; PG8_WAIT_L(0); PG8_MMA(1, 0, At, B0); PG8_BAR; PG8_SCHED;
            PG8_STAGE(PG8_SB(1, 1), b3 + hstepB, voffB);
            PG8_WAIT_V(6); PG8_BAR; PG8_MMA(1, 1, At, B1); PG8_BAR;
        }
        E(acc, cur, wr, wc, fr, fq);
        if (!has_next) break;
#pragma unroll
        for (int a = 0; a < 2; ++a)
#pragma unroll
            for (int b = 0; b < 2; ++b)
#pragma unroll
                for (int m = 0; m < 4; ++m)
#pragma unroll
                    for (int n = 0; n < 2; ++n) acc[a][b][m][n] = (f32x4){0.f, 0.f, 0.f, 0.f};
        cur = nxt; nt = cur.nt; cA = nA; cA2 = (const char*)g.A2 + (size_t)cur.pm * tstepA; cB = nB; ++ui;
    }
    PG8_WAIT_V(0);
    if (wr == 0) PG8_BAR;
    PG8_BAR;
#undef PG8_SA
#undef PG8_SB
#undef PG8_STAGE
#undef PG8_LDA
#undef PG8_LDB
#undef PG8_MMA
#undef PG8_WAIT_V
#undef PG8_WAIT_L
#undef PG8_BAR
#undef PG8_SCHED
#undef PG8_APTR
}

struct EpiInProj {
    static constexpr bool PERM = true, MIDSCALE = false;
    bf16_t *ZG, *XBC, *U, *V; float* DT; float* LNP;
    DI void operator()(const f32x4 (&acc)[2][2][4][2], const Unit& u, int wr, int wc, int fr, int fq) const {
        const int row0 = u.pm * BM + wr * 64 + fr;
        const int pn = u.pn;
        if (pn == 20) {
            if (wc == 0) {
#pragma unroll
                for (int ai = 0; ai < 2; ++ai)
#pragma unroll
                    for (int m = 0; m < 4; ++m) { float* rp = DT + (size_t)(row0 + ai * HALF + m * 16) * 32 + 8 * fq;
                        *(f32x4*)(rp) = acc[ai][0][m][0]; *(f32x4*)(rp + 4) = acc[ai][0][m][1]; }
            }
            return;
        }
        bf16_t* base; int colt, ldc, act;
        if (pn < 4) { base = ZG; colt = pn * 256; ldc = 1024; act = 1; }
        else if (pn < 12) { base = XBC; colt = (pn - 4) * 256; ldc = 2048; act = 0; }
        else if (pn < 16) { base = U; colt = (pn - 12) * 256; ldc = 1024; act = 2; }
        else { base = V; colt = (pn - 16) * 256; ldc = 1024; act = 2; }
        const int col0 = colt + wc * 32 + 8 * fq;
        const bool stats = pn >= 16;
#pragma unroll
        for (int ai = 0; ai < 2; ++ai)
#pragma unroll
            for (int m = 0; m < 4; ++m) { bf16_t* rowp = base + (size_t)(row0 + ai * HALF + m * 16) * ldc + col0;
                float s1 = 0.f, s2 = 0.f;
#pragma unroll
                for (int bj = 0; bj < 2; ++bj) { f32x4 v0 = acc[ai][bj][m][0], v1 = acc[ai][bj][m][1];
                    if (act == 1) { const f32x2 a = silu2((f32x2){v0[0], v0[1]}), b = silu2((f32x2){v0[2], v0[3]}), c = silu2((f32x2){v1[0], v1[1]}), d = silu2((f32x2){v1[2], v1[3]});
                        v0 = (f32x4){a.x, a.y, b.x, b.y}; v1 = (f32x4){c.x, c.y, d.x, d.y}; }
                    else if (act == 2) { const f32x2 a = gelu2((f32x2){v0[0], v0[1]}), b = gelu2((f32x2){v0[2], v0[3]}), c = gelu2((f32x2){v1[0], v1[1]}), d = gelu2((f32x2){v1[2], v1[3]});
                        v0 = (f32x4){a.x, a.y, b.x, b.y}; v1 = (f32x4){c.x, c.y, d.x, d.y}; }
                    if (stats) {
#pragma unroll
                        for (int j = 0; j < 4; ++j) { s1 += v0[j] + v1[j]; s2 += v0[j] * v0[j] + v1[j] * v1[j]; } }
                    u32x4 w; w.x = pk2(v0[0], v0[1]); w.y = pk2(v0[2], v0[3]); w.z = pk2(v1[0], v1[1]); w.w = pk2(v1[2], v1[3]);
                    *(u32x4*)(rowp + bj * HALF) = w; }
                if (stats) { s1 += __shfl_xor(s1, 16); s1 += __shfl_xor(s1, 32); s2 += __shfl_xor(s2, 16); s2 += __shfl_xor(s2, 32);
                    if (fq == 0) *(f32x2*)(LNP + ((size_t)(row0 + ai * HALF + m * 16) * 16 + (pn - 16) * 4 + wc) * 2) = (f32x2){s1, s2}; } }
    }
};
struct EpiRelu2 {
    static constexpr bool PERM = true, MIDSCALE = false;
    bf16_t* F;
    DI void operator()(const f32x4 (&acc)[2][2][4][2], const Unit& u, int wr, int wc, int fr, int fq) const {
        const int row0 = u.pm * BM + wr * 64 + fr, col0 = u.pn * BM + wc * 32 + 8 * fq;
#pragma unroll
        for (int ai = 0; ai < 2; ++ai)
#pragma unroll
            for (int m = 0; m < 4; ++m) { bf16_t* rowp = F + (size_t)(row0 + ai * HALF + m * 16) * 4096 + col0;
#pragma unroll
                for (int bj = 0; bj < 2; ++bj) { f32x4 v0 = acc[ai][bj][m][0], v1 = acc[ai][bj][m][1];
#pragma unroll
                    for (int j = 0; j < 4; ++j) { const float a = fmaxf(v0[j], 0.f), b = fmaxf(v1[j], 0.f); v0[j] = a * a; v1[j] = b * b; }
                    u32x4 w; w.x = pk2(v0[0], v0[1]); w.y = pk2(v0[2], v0[3]); w.z = pk2(v1[0], v1[1]); w.w = pk2(v1[2], v1[3]);
                    *(u32x4*)(rowp + bj * HALF) = w; } }
    }
};
struct EpiPartial {
    static constexpr bool PERM = true, MIDSCALE = false;
    const float* gate; const float* ssq; bf16_t* P0; bf16_t* P1;
    DI void operator()(const f32x4 (&acc)[2][2][4][2], const Unit& u, int wr, int wc, int fr, int fq) const {
        const int row0 = u.pm * BM + wr * 64 + fr, col0 = u.pn * BM + wc * 32 + 8 * fq;
        const float* gp = gate + (size_t)cond_of(u.pm * BM) * 6144 + col0;
        f32x4 gv[2][2];
#pragma unroll
        for (int bj = 0; bj < 2; ++bj)
#pragma unroll
            for (int n = 0; n < 2; ++n) gv[bj][n] = *(const f32x4*)(gp + bj * HALF + n * 4);
        bf16_t* P = u.kh ? P1 : P0;
        const bool scale = (u.kh == 0) && (ssq != nullptr);
#pragma unroll
        for (int ai = 0; ai < 2; ++ai)
#pragma unroll
            for (int m = 0; m < 4; ++m) { const int row = row0 + ai * HALF + m * 16; bf16_t* op = P + (size_t)row * DM + col0;
                float rs = 1.0f;
                if (scale) { const f32x4 s4 = *(const f32x4*)(ssq + (size_t)row * 4); rs = __builtin_amdgcn_rsqf(((s4[0] + s4[1]) + (s4[2] + s4[3])) * (1.0f / 1024.0f) + EPSF); }
#pragma unroll
                for (int bj = 0; bj < 2; ++bj) { const f32x4 v0 = gv[bj][0] * acc[ai][bj][m][0] * rs, v1 = gv[bj][1] * acc[ai][bj][m][1] * rs;
                    u32x4 w; w.x = pk2(v0[0], v0[1]); w.y = pk2(v0[2], v0[3]); w.z = pk2(v1[0], v1[1]); w.w = pk2(v1[2], v1[3]);
                    *(u32x4*)(op + bj * HALF) = w; } }
    }
};
struct EpiPartialQ3 {
    static constexpr bool PERM = true, MIDSCALE = true;
    const float* gate; const float* ssq; bf16_t* PA; bf16_t* PQ;
    DI void operator()(const f32x4 (&acc)[2][2][4][2], const Unit& u, int wr, int wc, int fr, int fq) const {
        const int row0 = u.pm * BM + wr * 64 + fr, col0 = u.pn * BM + wc * 32 + 8 * fq;
        const float* gp = gate + (size_t)cond_of(u.pm * BM) * 6144 + col0;
        f32x4 gv[2][2];
#pragma unroll
        for (int bj = 0; bj < 2; ++bj)
#pragma unroll
            for (int n = 0; n < 2; ++n) gv[bj][n] = *(const f32x4*)(gp + bj * HALF + n * 4);
        bf16_t* base = u.kh == 0 ? PA : PQ + ((size_t)(u.kh - 1) * 4096 - 16384) * DM;
        const bool scale = (u.nt != 32) && (u.kh < 2);
#pragma unroll
        for (int ai = 0; ai < 2; ++ai)
#pragma unroll
            for (int m = 0; m < 4; ++m) { const int row = row0 + ai * HALF + m * 16; bf16_t* op = base + (size_t)row * DM + col0;
                float rs = 1.0f;
                if (scale) { const f32x4 s4 = *(const f32x4*)(ssq + (size_t)row * 4); rs = __builtin_amdgcn_rsqf(((s4[0] + s4[1]) + (s4[2] + s4[3])) * (1.0f / 1024.0f) + EPSF); }
#pragma unroll
                for (int bj = 0; bj < 2; ++bj) { const f32x4 v0 = gv[bj][0] * acc[ai][bj][m][0] * rs, v1 = gv[bj][1] * acc[ai][bj][m][1] * rs;
                    u32x4 w; w.x = pk2(v0[0], v0[1]); w.y = pk2(v0[2], v0[3]); w.z = pk2(v1[0], v1[1]); w.w = pk2(v1[2], v1[3]);
                    *(u32x4*)(op + bj * HALF) = w; } }
    }
};
struct EpiPartialQ {
    static constexpr bool PERM = true, MIDSCALE = false;
    const float* gate; bf16_t* PA; bf16_t* PQ;
    DI void operator()(const f32x4 (&acc)[2][2][4][2], const Unit& u, int wr, int wc, int fr, int fq) const {
        const int row0 = u.pm * BM + wr * 64 + fr, col0 = u.pn * BM + wc * 32 + 8 * fq;
        const float* gp = gate + (size_t)cond_of(u.pm * BM) * 6144 + col0;
        f32x4 gv[2][2];
#pragma unroll
        for (int bj = 0; bj < 2; ++bj)
#pragma unroll
            for (int n = 0; n < 2; ++n) gv[bj][n] = *(const f32x4*)(gp + bj * HALF + n * 4);
        bf16_t* base = u.kh == 0 ? PA : PQ + ((size_t)(u.kh - 1) * 4096 - 16384) * DM;
#pragma unroll
        for (int ai = 0; ai < 2; ++ai)
#pragma unroll
            for (int m = 0; m < 4; ++m) { const int row = row0 + ai * HALF + m * 16; bf16_t* op = base + (size_t)row * DM + col0;
#pragma unroll
                for (int bj = 0; bj < 2; ++bj) { const f32x4 v0 = gv[bj][0] * acc[ai][bj][m][0], v1 = gv[bj][1] * acc[ai][bj][m][1];
                    u32x4 w; w.x = pk2(v0[0], v0[1]); w.y = pk2(v0[2], v0[3]); w.z = pk2(v1[0], v1[1]); w.w = pk2(v1[2], v1[3]);
                    *(u32x4*)(op + bj * HALF) = w; } }
    }
};
template <bool FROM_X, bool MS> struct EpiResid {
    static constexpr bool PERM = false, MIDSCALE = MS;
    const float* xp; const float* xs; const float* pe; const float* gate;
    float* out; bf16_t* Pb;
    DI void operator()(const f32x4 (&acc)[2][2][4][2], const Unit& u, int wr, int wc, int fr, int fq) const {
        const int row0 = u.pm * BM + wr * 64 + fr, col0 = u.pn * BM + wc * 32 + 4 * fq;
        const int tok0 = u.pm * BM;
        const float* gp = gate + (size_t)cond_of(tok0) * 6144 + col0;
        f32x4 gv[2][2];
#pragma unroll
        for (int bj = 0; bj < 2; ++bj)
#pragma unroll
            for (int n = 0; n < 2; ++n) gv[bj][n] = *(const f32x4*)(gp + bj * HALF + n * 16);
        if (u.kh != 0) {
#pragma unroll
            for (int ai = 0; ai < 2; ++ai)
#pragma unroll
                for (int m = 0; m < 4; ++m) { bf16_t* op = Pb + (size_t)(row0 + ai * HALF + m * 16) * DM + col0;
#pragma unroll
                    for (int bj = 0; bj < 2; ++bj)
#pragma unroll
                        for (int n = 0; n < 2; ++n) { const f32x4 v = gv[bj][n] * acc[ai][bj][m][n]; u32x2 o; o.x = pk2(v[0], v[1]); o.y = pk2(v[2], v[3]); *(u32x2*)(op + bj * HALF + n * 16) = o; } }
            return;
        }
#pragma unroll
        for (int ai = 0; ai < 2; ++ai)
#pragma unroll
            for (int m = 0; m < 4; ++m) { const int row = row0 + ai * HALF + m * 16; float* op = out + (size_t)row * DM + col0;
                const float* bp; const float* pp = nullptr;
                if (FROM_X) { bp = (row < NPR ? xp + (size_t)row * DM : xs + (size_t)(row - NPR) * DM) + col0;
                    if (row >= NPR) { const int pos = (row - NPR) & 4095; const int pr = (col0 < 512) ? (pos >> 6) : (pos & 63); pp = pe + pr * 512 + (col0 & 511); } }
                else bp = op;
#pragma unroll
                for (int bj = 0; bj < 2; ++bj)
#pragma unroll
                    for (int n = 0; n < 2; ++n) { f32x4 b = *(const f32x4*)(bp + bj * HALF + n * 16);
                        if (FROM_X) { if (pp) b += *(const f32x4*)(pp + bj * HALF + n * 16); }
                        *(f32x4*)(op + bj * HALF + n * 16) = b + gv[bj][n] * acc[ai][bj][m][n]; }
                asm volatile("" ::: "memory"); }
    }
};
}

DI void p0_ada_item(const Params& p, LAS unsigned char* lds, int item) {
    LAS float* sc = (LAS float*)lds;
    LAS float* red = (LAS float*)(lds + 20480);
    const int tid = otid(), wid = tid >> 6, lane = tid & 63;
    for (int i = tid; i < 5 * 1024; i += 512) { const int c = i >> 10, k = i & 1023; const float v = c == 0 ? p.in[4][k] : p.in[3][(c - 1) * 1024 + k]; sc[i] = silu_f(v); }
    __syncthreads();
    const int kk = lane >> 4, c4 = lane & 15, k0 = wid * 128;
    const float* W = p.in[5] + (size_t)(k0 + kk) * 6144 + item * 64 + c4 * 4;
    f32x4 a[5];
#pragma unroll
    for (int c = 0; c < 5; ++c) a[c] = (f32x4){0.f, 0.f, 0.f, 0.f};
#pragma unroll 8
    for (int i = 0; i < 32; ++i) { const f32x4 w = __builtin_nontemporal_load((const f32x4*)(W + (size_t)i * 4 * 6144)); const int k = k0 + 4 * i + kk;
#pragma unroll
        for (int c = 0; c < 5; ++c) a[c] += w * sc[c * 1024 + k]; }
#pragma unroll
    for (int c = 0; c < 5; ++c)
#pragma unroll
        for (int e = 0; e < 4; ++e) { float v = a[c][e]; v += __shfl_xor(v, 16); v += __shfl_xor(v, 32); a[c][e] = v; }
    if (kk == 0) {
#pragma unroll
        for (int c = 0; c < 5; ++c) *(LAS f32x4*)(red + (wid * 5 + c) * 64 + c4 * 4) = a[c]; }
    __syncthreads();
    if (tid < 320) { const int c = tid >> 6, l = tid & 63; float sum = 0.f;
#pragma unroll
        for (int w = 0; w < 8; ++w) sum += red[(w * 5 + c) * 64 + l];
        const int cc = item * 64 + l;
        ((float*)(p.ws + OFF_MOD))[c * 6144 + cc] = sum + p.in[6][cc]; }
    __syncthreads();
}
DI int win_rowmap(int n0) {
    if (n0 < 3072) return n0;
    if (n0 < 3104) return 5120 + (n0 - 3072);
    if (n0 < 4128) return 3072 + (n0 - 3104);
    return 4096 + (n0 - 4128);
}
template <int NB, bool WINMAP> DI void p0_tr_item(const float* W, int K, int N, bf16_t* WT, int kb, int nb0, int nbmax, const float* kscale, LAS unsigned char* lds) {
    LAS float* t = (LAS float*)lds;
    const int tid = otid();
    const int k0 = kb * 128;
    f32x4 v[NB][2];
#pragma unroll
    for (int b = 0; b < NB; ++b) { const int nb = nb0 + b;
#pragma unroll
        for (int ps = 0; ps < 2; ++ps) { const int r = ps * 64 + (tid >> 3), c4 = (tid & 7) * 4;
            v[b][ps] = nb < nbmax ? __builtin_nontemporal_load((const f32x4*)(W + (size_t)(k0 + r) * N + nb * 32 + c4)) : (f32x4){0.f, 0.f, 0.f, 0.f}; } }
    float sk[2];
#pragma unroll
    for (int ps = 0; ps < 2; ++ps) sk[ps] = kscale ? kscale[k0 + ps * 64 + (tid >> 3)] : 1.0f;
#pragma unroll
    for (int b = 0; b < NB; ++b)
#pragma unroll
        for (int ps = 0; ps < 2; ++ps) { const int r = ps * 64 + (tid >> 3), c4 = (tid & 7) * 4; LAS float* tp = t + b * (128 * 33) + r * 33 + c4;
            tp[0] = v[b][ps][0] * sk[ps]; tp[1] = v[b][ps][1] * sk[ps]; tp[2] = v[b][ps][2] * sk[ps]; tp[3] = v[b][ps][3] * sk[ps]; }
    __syncthreads();
#pragma unroll
    for (int b = 0; b < NB; ++b) { const int nb = nb0 + b;
        if (nb < nbmax) { const int n = tid >> 4, kc = (tid & 15) * 8; const LAS float* tb = t + b * (128 * 33);
            const int drow = WINMAP ? win_rowmap(nb * 32) : nb * 32;
            u32x4 o; o.x = pk2(tb[(kc + 0) * 33 + n], tb[(kc + 1) * 33 + n]); o.y = pk2(tb[(kc + 2) * 33 + n], tb[(kc + 3) * 33 + n]);
            o.z = pk2(tb[(kc + 4) * 33 + n], tb[(kc + 5) * 33 + n]); o.w = pk2(tb[(kc + 6) * 33 + n], tb[(kc + 7) * 33 + n]);
            *(u32x4*)(WT + (size_t)(drow + n) * K + k0 + kc) = o; } }
    __syncthreads();
}
DI void phase0a(const Params& p, LAS unsigned char* lds) {
    const int tid = otid();
    constexpr int N_ADA = 96, N_PE = 64, N_Z = 28;
    for (int it = blockIdx.x; it < N_ADA + N_PE + N_Z; it += gridDim.x) {
        if (it < N_ADA) p0_ada_item(p, lds, it);
        else if (it >= N_ADA + N_PE) { const int j = it - N_ADA - N_PE; u32x4* z = (u32x4*)((bf16_t*)(p.ws + OFF_WIN) + (size_t)5152 * 1024) + (size_t)j * 1024 + tid; z[0] = (u32x4){0u, 0u, 0u, 0u}; z[512] = (u32x4){0u, 0u, 0u, 0u}; }
        else { const int j = it - N_ADA; const int e = j * 512 + tid; const int pos = e >> 9, f = e & 255, isc = (e >> 8) & 1;
            const float om = ex2(-(float)f * (13.287712379549449f / 256.0f));
            float ang = (float)pos * om;
            const float kk = rintf(ang * 0.15915494309189535f); ang = fmaf(-kk, 6.2831854820251465f, ang); ang = fmaf(-kk, -1.7484556e-07f, ang);
            ((float*)(p.ws + OFF_PE))[e] = isc ? __cosf(ang) : __sinf(ang); }
    }
}
DI void phase0b(const Params& p, LAS unsigned char* lds, int first, int last, int b0, int stride) {
    const int tid = otid();
    constexpr int N_WIN = 8 * 41, N_WOUT = 16 * 8, N_FF1 = 8 * 32, N_FF2 = 32 * 8, N_WSB = 32;
    constexpr int E2 = N_WIN, E3 = E2 + N_WOUT, E4 = E3 + N_FF1, E5 = E4 + N_FF2, E6 = E5 + N_WSB;
    if (last > E6) last = E6;
    if (b0 < 0) return;
    for (int it = first + b0; it < last; it += stride) {
        if (it < E2) { const int j = it, nbb = j % 41, kb = j / 41; p0_tr_item<4, true>(p.in[8], 1024, 5152, (bf16_t*)(p.ws + OFF_WIN), kb, nbb * 4, 161, nullptr, lds); }
        else if (it < E3) { const int j = it - E2, nbb = j % 8, kb = j / 8; p0_tr_item<4, false>(p.in[19], 2048, 1024, (bf16_t*)(p.ws + OFF_WOUT), kb, nbb * 4, 32, kb < 8 ? p.in[14] : nullptr, lds); }
        else if (it < E4) { const int j = it - E3, nbb = j % 32, kb = j / 32; p0_tr_item<4, false>(p.in[21], 1024, 4096, (bf16_t*)(p.ws + OFF_WFF1), kb, nbb * 4, 128, nullptr, lds); }
        else if (it < E5) { const int j = it - E4, nbb = j % 8, kb = j / 8; p0_tr_item<4, false>(p.in[22], 4096, 1024, (bf16_t*)(p.ws + OFF_WFF2), kb, nbb * 4, 32, nullptr, lds); }
        else { const int j = it - E5; const int e = (j * 512 + tid) * 8; const f32x4 a = *(const f32x4*)(p.in[17] + e), b = *(const f32x4*)(p.in[17] + e + 4);
            u32x4 o; o.x = pk2(a[0], a[1]); o.y = pk2(a[2], a[3]); o.z = pk2(b[0], b[1]); o.w = pk2(b[2], b[3]); *(u32x4*)((bf16_t*)(p.ws + OFF_WSB) + e) = o; }
    }
}

template <int RB, int NQ> struct RowBufN { f32x4 v[RB][4]; u32x2 q[NQ > 0 ? NQ : 1][RB][4]; };
template <int WHICH, int NQ> DI void norm_mod_rows(const Params& p, int row_lo, int row_hi) {
    const int t_ = otid(); const int lane = t_ & 63, gw = blockIdx.x * 8 + (t_ >> 6), nw = gridDim.x * 8;
    const float* g = WHICH == 0 ? p.in[7] : p.in[20];
    const float* mod = (const float*)(p.ws + OFF_MOD);
    const float* pe = (const float*)(p.ws + OFF_PE);
    bf16_t* Hb = (bf16_t*)(p.ws + OFF_HB);
    const bf16_t* Pa = (const bf16_t*)(p.ws + OFF_P3A); const bf16_t* Pq = (const bf16_t*)(p.ws + OFF_P3B);
    constexpr int RB = WHICH == 0 ? 4 : (NQ == 4 ? 1 : 2);
    typedef RowBufN<RB, NQ> Buf;
    int ccur = -1; f32x4 pa[4], pb[4];
    auto load = [&](Buf& B, int row0) {
#pragma unroll
        for (int r = 0; r < RB; ++r) { const int row = row0 + r; const float* xr = xrow_ptr(p, row);
#pragma unroll
            for (int j = 0; j < 4; ++j) { B.v[r][j] = __builtin_nontemporal_load((const f32x4*)(xr + 4 * lane + 256 * j));
                if (NQ >= 1) B.q[0][r][j] = *(const u32x2*)(Pa + (size_t)row * DM + 4 * lane + 256 * j);
                if (NQ == 4) {
#pragma unroll
                    for (int k = 1; k < 4; ++k) B.q[k][r][j] = *(const u32x2*)(Pq + ((size_t)(k - 1) * 4096 + (row - 16384)) * DM + 4 * lane + 256 * j); } } }
    };
    auto process = [&](Buf& B, int row0) {
        float s[RB];
        const int cnd = cond_of(row0);
        if (cnd != ccur) { ccur = cnd; const float* mc = mod + (size_t)cnd * 6144 + (WHICH == 0 ? 0 : 3072);
#pragma unroll
            for (int j = 0; j < 4; ++j) { const int c = 4 * lane + 256 * j; pa[j] = *(const f32x4*)(g + c) * (*(const f32x4*)(mc + 1024 + c) + 1.0f); pb[j] = *(const f32x4*)(mc + c); } }
#pragma unroll
        for (int r = 0; r < RB; ++r) { const int row = row0 + r; s[r] = 0.f;
#pragma unroll
            for (int j = 0; j < 4; ++j) {
                if (row >= NPR) { const int pos = (row - NPR) & 4095; const int pr = j < 2 ? (pos >> 6) : (pos & 63); B.v[r][j] += *(const f32x4*)(pe + pr * 512 + ((4 * lane + 256 * j) & 511)); }
                if (NQ >= 1) {
#pragma unroll
                    for (int k = 0; k < (NQ > 0 ? NQ : 1); ++k) B.v[r][j] += (f32x4){bflo(B.q[k][r][j].x), bfhi(B.q[k][r][j].x), bflo(B.q[k][r][j].y), bfhi(B.q[k][r][j].y)};
                    *(f32x4*)(p.out + (size_t)row * DM + 4 * lane + 256 * j) = B.v[r][j]; }
                s[r] += (B.v[r][j][0] * B.v[r][j][0] + B.v[r][j][1] * B.v[r][j][1]) + (B.v[r][j][2] * B.v[r][j][2] + B.v[r][j][3] * B.v[r][j][3]); } }
#pragma unroll
        for (int o = 1; o < 64; o <<= 1) {
#pragma unroll
            for (int r = 0; r < RB; ++r) s[r] += __shfl_xor(s[r], o); }
#pragma unroll
        for (int r = 0; r < RB; ++r) { const int row = row0 + r;
            const float rstd = __builtin_amdgcn_rsqf(s[r] * (1.0f / 1024.0f) + EPSF);
#pragma unroll
            for (int j = 0; j < 4; ++j) { const int c = 4 * lane + 256 * j;
                const f32x4 h = B.v[r][j] * rstd * pa[j] + pb[j];
                u32x2 o; o.x = pk2(h[0], h[1]); o.y = pk2(h[2], h[3]); *(u32x2*)(Hb + (size_t)row * DM + c) = o; } }
    };
    Buf A, B2; const int step = nw * RB;
    int r0 = row_lo + gw * RB;
    if (r0 < row_hi) load(A, r0);
    while (r0 < row_hi) {
        const int r1 = r0 + step;
        if (r1 < row_hi) load(B2, r1);
        process(A, r0);
        if (r1 >= row_hi) break;
        const int r2 = r1 + step;
        if (r2 < row_hi) load(A, r2);
        process(B2, r1);
        r0 = r2;
    }
}
template <int WHICH> DI void phase_norm_mod(const Params& p) {
    if (WHICH == 0) norm_mod_rows<0, 0>(p, 0, MT);
    else { norm_mod_rows<1, 1>(p, 0, 16384); norm_mod_rows<1, 4>(p, 16384, MT); }
}
template <bool LATE> struct RowBufF { f32x4 v[2][4]; u32x2 qa[2][4]; u32x2 q1[LATE ? 2 : 1][4], q2[LATE ? 2 : 1][4], q3[LATE ? 2 : 1][4]; };
template <bool LATE> DI void final_norm_rows(const Params& p, int row_lo, int row_hi) {
    const int t_ = otid(); const int lane = t_ & 63, gw = blockIdx.x * 8 + (t_ >> 6), nw = gridDim.x * 8;
    const float* g = p.in[23];
    const bf16_t* Pa = (const bf16_t*)(p.ws + OFF_P5A); const bf16_t* Pq = (const bf16_t*)(p.ws + OFF_P5B);
    constexpr int RB = 2;
    typedef RowBufF<LATE> Buf;
    f32x4 gg[4];
#pragma unroll
    for (int j = 0; j < 4; ++j) gg[j] = *(const f32x4*)(g + 4 * lane + 256 * j);
    auto load = [&](Buf& B, int row0) {
#pragma unroll
        for (int r = 0; r < RB; ++r) { const size_t ro = (size_t)(row0 + r) * DM + 4 * lane; const size_t rq = (size_t)(row0 + r - 16384) * DM + 4 * lane;
#pragma unroll
            for (int j = 0; j < 4; ++j) { B.v[r][j] = *(const f32x4*)(p.out + ro + 256 * j); B.qa[r][j] = *(const u32x2*)(Pa + ro + 256 * j);
                if (LATE) { B.q1[r][j] = *(const u32x2*)(Pq + rq + 256 * j); B.q2[r][j] = *(const u32x2*)(Pq + (size_t)4096 * DM + rq + 256 * j); B.q3[r][j] = *(const u32x2*)(Pq + (size_t)8192 * DM + rq + 256 * j); } } }
    };
    auto process = [&](Buf& B, int row0) {
        float s[RB];
#pragma unroll
        for (int r = 0; r < RB; ++r) { s[r] = 0.f;
#pragma unroll
            for (int j = 0; j < 4; ++j) { B.v[r][j] += (f32x4){bflo(B.qa[r][j].x), bfhi(B.qa[r][j].x), bflo(B.qa[r][j].y), bfhi(B.qa[r][j].y)};
                if (LATE) { B.v[r][j] += (f32x4){bflo(B.q1[r][j].x) + bflo(B.q2[r][j].x) + bflo(B.q3[r][j].x), bfhi(B.q1[r][j].x) + bfhi(B.q2[r][j].x) + bfhi(B.q3[r][j].x),
                                                  bflo(B.q1[r][j].y) + bflo(B.q2[r][j].y) + bflo(B.q3[r][j].y), bfhi(B.q1[r][j].y) + bfhi(B.q2[r][j].y) + bfhi(B.q3[r][j].y)}; }
                s[r] += (B.v[r][j][0] * B.v[r][j][0] + B.v[r][j][1] * B.v[r][j][1]) + (B.v[r][j][2] * B.v[r][j][2] + B.v[r][j][3] * B.v[r][j][3]); } }
#pragma unroll
        for (int o = 1; o < 64; o <<= 1) {
#pragma unroll
            for (int r = 0; r < RB; ++r) s[r] += __shfl_xor(s[r], o); }
#pragma unroll
        for (int r = 0; r < RB; ++r) { float* xr = p.out + (size_t)(row0 + r) * DM;
            const float rstd = __builtin_amdgcn_rsqf(s[r] * (1.0f / 1024.0f) + EPSF);
#pragma unroll
            for (int j = 0; j < 4; ++j) { const int c = 4 * lane + 256 * j; __builtin_nontemporal_store(B.v[r][j] * rstd * gg[j], (f32x4*)(xr + c)); } }
    };
    Buf A, B2; const int step = nw * RB;
    int r0 = row_lo + gw * RB;
    if (r0 < row_hi) load(A, r0);
    while (r0 < row_hi) {
        const int r1 = r0 + step;
        if (r1 < row_hi) load(B2, r1);
        process(A, r0);
        if (r1 >= row_hi) break;
        const int r2 = r1 + step;
        if (r2 < row_hi) load(A, r2);
        process(B2, r1);
        r0 = r2;
    }
}
DI void phase_final_norm(const Params& p) {
    final_norm_rows<false>(p, 0, 16384);
    final_norm_rows<true>(p, 16384, MT);
}

template <bool WITH_C> DI void stage_conv(const Params& p, int cidx, int g, LAS unsigned char* Ximg, LAS unsigned char* Bimg, int bstride, LAS unsigned char* Cimg) {
    int tid_ = threadIdx.x; asm volatile("" : "+v"(tid_));
    const int tid = tid_, co = tid & 63, rg = tid >> 6;
    if (WITH_C || co < 48) {
        const bf16_t* XBC = (const bf16_t*)p.out;
        const int ch = co < 32 ? g * 256 + co * 8 : (co < 48 ? 1024 + g * 128 + (co - 32) * 8 : 1536 + g * 128 + (co - 48) * 8);
        LAS unsigned char* dst = co < 32 ? Ximg + co * 16 : (co < 48 ? Bimg + (co - 32) * 16 : Cimg + (co - 48) * 16);
        const int dstride = co < 32 ? 544 : (co < 48 ? bstride : 272);
        const int tok0 = cidx * 128;
        const int seq_lo = tok0 < NPR ? (tok0 & ~255) : (NPR + ((tok0 - NPR) & ~4095));
        const int seq_hi = seq_lo + (tok0 < NPR ? 256 : 4096);
        f32x2 wv[5][4], bv[4];
#pragma unroll
        for (int k = 0; k < 5; ++k) { const f32x4 a = *(const f32x4*)(p.in[9] + k * 2048 + ch), b = *(const f32x4*)(p.in[9] + k * 2048 + ch + 4);
            wv[k][0] = (f32x2){a[0], a[1]}; wv[k][1] = (f32x2){a[2], a[3]}; wv[k][2] = (f32x2){b[0], b[1]}; wv[k][3] = (f32x2){b[2], b[3]}; }
        { const f32x4 a = *(const f32x4*)(p.in[10] + ch), b = *(const f32x4*)(p.in[10] + ch + 4);
          bv[0] = (f32x2){a[0], a[1]}; bv[1] = (f32x2){a[2], a[3]}; bv[2] = (f32x2){b[0], b[1]}; bv[3] = (f32x2){b[2], b[3]}; }
#pragma unroll 1
        for (int hf = 0; hf < 2; ++hf) {
            const int rl = rg * 16 + 8 * hf, tb = tok0 + rl;
            u32x4 raw[12];
#pragma unroll
            for (int r = 0; r < 12; ++r) { const int t = tb - 2 + r; raw[r] = (t >= seq_lo && t < seq_hi) ? *(const u32x4*)(XBC + (size_t)t * 2048 + ch) : (u32x4){0u, 0u, 0u, 0u}; }
            f32x2 xw[12][4];
#pragma unroll
            for (int r = 0; r < 12; ++r) { xw[r][0] = (f32x2){bflo(raw[r].x), bfhi(raw[r].x)}; xw[r][1] = (f32x2){bflo(raw[r].y), bfhi(raw[r].y)};
                xw[r][2] = (f32x2){bflo(raw[r].z), bfhi(raw[r].z)}; xw[r][3] = (f32x2){bflo(raw[r].w), bfhi(raw[r].w)}; }
#pragma unroll
            for (int i = 0; i < 8; ++i) {
                f32x2 o[4];
#pragma unroll
                for (int c = 0; c < 4; ++c) { o[c] = bv[c];
#pragma unroll
                    for (int k = 0; k < 5; ++k) o[c] = __builtin_elementwise_fma(wv[k][c], xw[i + k][c], o[c]);
                    const f32x2 t = o[c] * (-LOG2E); f32x2 d; d.x = ex2(t.x); d.y = ex2(t.y); d = d + 1.0f;
                    f32x2 r; r.x = __builtin_amdgcn_rcpf(d.x); r.y = __builtin_amdgcn_rcpf(d.y); o[c] = o[c] * r; }
                u32x4 ov; ov.x = pk2(o[0].x, o[0].y); ov.y = pk2(o[1].x, o[1].y); ov.z = pk2(o[2].x, o[2].y); ov.w = pk2(o[3].x, o[3].y);
                *(LAS u32x4*)(dst + (rl + i) * dstride) = ov;
            }
        }
    }
}

DI void p23_item(const Params& p, LAS unsigned char* lds, int cidx, int g) {
    int tid_ = threadIdx.x; asm volatile("" : "+v"(tid_));
    const int tid = tid_, wid = __builtin_amdgcn_readfirstlane(tid >> 6), lane = tid & 63, i16 = lane & 15, G = lane >> 4;
    bf16_t* S = (bf16_t*)(p.ws + OFF_S);
    const int tok0 = cidx * 128;
    LAS unsigned char* Ximg = lds;
    LAS unsigned char* Bimg = lds + 69632;
    LAS float* WT = (LAS float*)(lds + 106496);
    LAS float* DTs = (LAS float*)(lds + 129024);
    LAS float* A2s = (LAS float*)(lds + 133120);
    if (wid == 0) {
        const int seg = lane & 7, dhl = lane >> 3, d = dhl >> 2, dh = d * 16 + 4 * g + (dhl & 3);
        const float* DT = (const float*)(p.ws + OFF_DT);
        f32x2* DTA = (f32x2*)(p.ws + OFF_DTA);
        const float dtb = p.in[11][dh], A2 = -__expf(p.in[12][dh]) * LOG2E;
        float dt[16]; float tot = 0.f;
#pragma unroll
        for (int jj = 0; jj < 16; ++jj) { const int o = seg * 16 + jj; const int j = d ? 127 - o : o;
            const float x = DT[(size_t)(tok0 + j) * 32 + dh] + dtb;
            dt[jj] = fmaxf(x, 0.f) + log1pf(__expf(-fabsf(x))); tot += dt[jj] * A2; }
        float inc = tot;
#pragma unroll
        for (int o = 1; o < 8; o <<= 1) { const float t = __shfl_up(inc, o, 8); if (seg >= o) inc += t; }
        float run = inc - tot;
#pragma unroll
        for (int jj = 0; jj < 16; ++jj) { const int o = seg * 16 + jj; const int j = d ? 127 - o : o;
            run += dt[jj] * A2; DTA[(size_t)(tok0 + j) * 32 + dh] = (f32x2){dt[jj], run}; DTs[dhl * 128 + j] = dt[jj]; A2s[dhl * 128 + j] = run; }
    }
    stage_conv<false>(p, cidx, g, Ximg, Bimg, 288, nullptr);
    __syncthreads();
#pragma unroll
    for (int r = 0; r < 2; ++r) { const int j = tid & 127, dhl = (tid >> 7) + 4 * r, d = dhl >> 2;
        WT[dhl * 128 + j] = DTs[dhl * 128 + j] * ex2(A2s[dhl * 128 + (d ? 0 : 127)] - A2s[dhl * 128 + j]); }
    __syncthreads();
    const int hl = wid >> 1, d = wid & 1, dhl = d * 4 + hl;
    bf16_t* So = S + ((size_t)(cidx * 2 + d) * 16 + 4 * g + hl) * 8192;
#pragma unroll 1
    for (int nh = 0; nh < 2; ++nh) {
        f32x4 acc[4][4];
#pragma unroll
        for (int a = 0; a < 4; ++a)
#pragma unroll
            for (int b = 0; b < 4; ++b) acc[a][b] = (f32x4){0.f, 0.f, 0.f, 0.f};
#pragma unroll 1
        for (int ks = 0; ks < 4; ++ks) {
            const int r0 = 32 * ks + 4 * G + (i16 >> 2), cb = 4 * (i16 & 3);
            bf16x8 bfr[4];
#pragma unroll
            for (int nt = 0; nt < 4; ++nt) bfr[nt] = cat8(trrd(Bimg + r0 * 288 + (64 * nh + 16 * nt + cb) * 2), trrd(Bimg + (r0 + 16) * 288 + (64 * nh + 16 * nt + cb) * 2));
            const f32x4 w0 = *(const LAS f32x4*)(WT + dhl * 128 + 32 * ks + 4 * G), w1 = *(const LAS f32x4*)(WT + dhl * 128 + 32 * ks + 16 + 4 * G);
#pragma unroll
            for (int pt = 0; pt < 4; ++pt) {
                const s16x4 xa = trrd(Ximg + r0 * 544 + (hl * 64 + 16 * pt + cb) * 2), xb = trrd(Ximg + (r0 + 16) * 544 + (hl * 64 + 16 * pt + cb) * 2);
                u32x4 xs;
                xs.x = pk2(__uint_as_float((unsigned)(unsigned short)xa[0] << 16) * w0[0], __uint_as_float((unsigned)(unsigned short)xa[1] << 16) * w0[1]);
                xs.y = pk2(__uint_as_float((unsigned)(unsigned short)xa[2] << 16) * w0[2], __uint_as_float((unsigned)(unsigned short)xa[3] << 16) * w0[3]);
                xs.z = pk2(__uint_as_float((unsigned)(unsigned short)xb[0] << 16) * w1[0], __uint_as_float((unsigned)(unsigned short)xb[1] << 16) * w1[1]);
                xs.w = pk2(__uint_as_float((unsigned)(unsigned short)xb[2] << 16) * w1[2], __uint_as_float((unsigned)(unsigned short)xb[3] << 16) * w1[3]);
                const bf16x8 xf = u4_as_bf8(xs);
#pragma unroll
                for (int nt = 0; nt < 4; ++nt) acc[nt][pt] = __builtin_amdgcn_mfma_f32_16x16x32_bf16(bfr[nt], xf, acc[nt][pt], 0, 0, 0);
            }
        }
        LAS unsigned char* T = lds + 110592 + wid * 2304;
#pragma unroll
        for (int pt = 0; pt < 4; ++pt) {
#pragma unroll
            for (int nt = 0; nt < 4; ++nt) { u32x2 o; o.x = pk2(acc[nt][pt][0], acc[nt][pt][1]); o.y = pk2(acc[nt][pt][2], acc[nt][pt][3]);
                *(LAS u32x2*)(T + i16 * 144 + (16 * nt + 4 * G) * 2) = o; }
#pragma unroll
            for (int j = 0; j < 2; ++j) { const int q = lane + 64 * j, row = q >> 3, c = q & 7;
                *(u32x4*)(So + (16 * pt + row) * 128 + 64 * nh + 8 * c) = *(const LAS u32x4*)(T + row * 144 + c * 16); }
        }
    }
    __syncthreads();
}
DI void p3_cmlp_item(const Params& p, LAS unsigned char* lds, int cidx, int hh) {
    int tid_ = threadIdx.x; asm volatile("" : "+v"(tid_));
    const int tid = tid_, wid = __builtin_amdgcn_readfirstlane(tid >> 6), lane = tid & 63, i16 = lane & 15, G = lane >> 4;
    const bf16_t* VN = (const bf16_t*)(p.ws + OFF_V);
    const bf16_t* Wsb = (const bf16_t*)(p.ws + OFF_WSB) + (size_t)hh * 16384;
    bf16_t* U = (bf16_t*)(p.ws + OFF_U);
    const int tok0 = cidx * 128;
    LAS unsigned char* Vimg = lds;
    LAS unsigned char* Wimg = lds + 36864;
    {
        const float* LNP = (const float*)(p.ws + OFF_LNP);
        LAS f32x2* STs = (LAS f32x2*)(lds + 71680);
        const int cc = tid & 15;
        u32x4 vv[4], ww[4];
#pragma unroll
        for (int itr = 0; itr < 4; ++itr) { const int row = itr * 32 + (tid >> 4);
            vv[itr] = *(const u32x4*)(VN + (size_t)(tok0 + row) * DM + hh * 128 + cc * 8);
            ww[itr] = *(const u32x4*)(Wsb + row * 128 + cc * 8); }
        if (tid < 128) { float s1 = 0.f, s2 = 0.f;
#pragma unroll
            for (int k = 0; k < 8; ++k) { const f32x4 t = *(const f32x4*)(LNP + (size_t)(tok0 + tid) * 32 + 4 * k); s1 += t[0] + t[2]; s2 += t[1] + t[3]; }
            const float mu = s1 * (1.0f / 1024.0f);
            STs[tid] = (f32x2){mu, __builtin_amdgcn_rsqf(fmaxf(s2 * (1.0f / 1024.0f) - mu * mu, 0.f) + EPSF)}; }
        const f32x4 g0 = *(const f32x4*)(p.in[15] + hh * 128 + cc * 8), g1 = *(const f32x4*)(p.in[15] + hh * 128 + cc * 8 + 4);
        const f32x4 b0 = *(const f32x4*)(p.in[16] + hh * 128 + cc * 8), b1 = *(const f32x4*)(p.in[16] + hh * 128 + cc * 8 + 4);
        __syncthreads();
#pragma unroll
        for (int itr = 0; itr < 4; ++itr) { const int row = itr * 32 + (tid >> 4);
            const f32x2 st = STs[row]; const float mu = st[0], rstd = st[1];
            const u32x4 a = vv[itr]; u32x4 o;
            o.x = pk2((bflo(a.x) - mu) * rstd * g0[0] + b0[0], (bfhi(a.x) - mu) * rstd * g0[1] + b0[1]); o.y = pk2((bflo(a.y) - mu) * rstd * g0[2] + b0[2], (bfhi(a.y) - mu) * rstd * g0[3] + b0[3]);
            o.z = pk2((bflo(a.z) - mu) * rstd * g1[0] + b1[0], (bfhi(a.z) - mu) * rstd * g1[1] + b1[1]); o.w = pk2((bflo(a.w) - mu) * rstd * g1[2] + b1[2], (bfhi(a.w) - mu) * rstd * g1[3] + b1[3]);
            *(LAS u32x4*)(Vimg + row * 288 + cc * 16) = o;
            *(LAS u32x4*)(Wimg + row * 272 + cc * 16) = ww[itr]; }
    }
    __syncthreads();
    bf16x8 wf[4];
#pragma unroll
    for (int ks = 0; ks < 4; ++ks) { const u32x2 a = *(const LAS u32x2*)(Wimg + (16 * wid + i16) * 272 + (32 * ks + 4 * G) * 2), b = *(const LAS u32x2*)(Wimg + (16 * wid + i16) * 272 + (32 * ks + 16 + 4 * G) * 2);
        wf[ks] = u4_as_bf8((u32x4){a.x, a.y, b.x, b.y}); }
    const int tok = tok0 + 16 * wid + i16;
    const float bs = p.in[18][hh * 128 + 16 * wid + i16];
#pragma unroll
    for (int mt = 0; mt < 8; ++mt) {
        f32x4 acc = (f32x4){0.f, 0.f, 0.f, 0.f};
#pragma unroll
        for (int ks = 0; ks < 4; ++ks) { const int r0 = 32 * ks + 4 * G + (i16 >> 2), cb = 16 * mt + 4 * (i16 & 3);
            const bf16x8 vf = cat8(trrd(Vimg + r0 * 288 + cb * 2), trrd(Vimg + (r0 + 16) * 288 + cb * 2));
            acc = __builtin_amdgcn_mfma_f32_16x16x32_bf16(vf, wf[ks], acc, 0, 0, 0); }
        bf16_t* up = U + (size_t)tok * DM + hh * 128 + 16 * mt + 4 * G;
        const u32x2 uu = *(const u32x2*)up;
        u32x2 o; o.x = pk2(bflo(uu.x) * (acc[0] + bs), bfhi(uu.x) * (acc[1] + bs)); o.y = pk2(bflo(uu.y) * (acc[2] + bs), bfhi(uu.y) * (acc[3] + bs));
        *(u32x2*)up = o;
    }
    __syncthreads();
}
DI void phase3(const Params& p, LAS unsigned char* lds) {
    const int b = blockIdx.x;
    if (gridDim.x == 256) {
        for (int it = b; it < 640; it += 256) p23_item(p, lds, it >> 2, it & 3);
        if (b >= 128) for (int k = 0; k < 5; ++k) { const int it = (b - 128) * 5 + k; p3_cmlp_item(p, lds, it >> 3, it & 7); }
    } else {
        for (int it = b; it < 1920; it += gridDim.x) {
            if (it < 640) p23_item(p, lds, it >> 2, it & 3);
            else p3_cmlp_item(p, lds, (it - 640) >> 3, (it - 640) & 7);
        }
    }
}

DI void phase4(const Params& p) {
    bf16_t* S = (bf16_t*)(p.ws + OFF_S);
    const f32x2* DTA = (const f32x2*)(p.ws + OFF_DTA);
    float* nst = p.out + (size_t)MT * DM;
    const int gt = blockIdx.x * 512 + otid(), ngt = gridDim.x * 512;
    for (int idx = gt; idx < 131072 + 524288; idx += ngt) {
        const bool samp = idx < 131072;
        const int id2 = samp ? idx : idx - 131072;
        const int sq = id2 >> 15, rem = id2 & 32767, d = rem >> 14, h = (rem >> 10) & 15, pn = rem & 1023;
        const int c0 = samp ? 32 + sq * 32 : sq * 2, nc = samp ? 32 : 2;
        float hc[8];
        if (samp) { const float* h0 = p.in[2] + ((size_t)(sq * 2 + d) * 16 + h) * 8192 + pn * 8; const f32x4 a = __builtin_nontemporal_load((const f32x4*)h0), b = __builtin_nontemporal_load((const f32x4*)(h0 + 4));
            hc[0] = a[0]; hc[1] = a[1]; hc[2] = a[2]; hc[3] = a[3]; hc[4] = b[0]; hc[5] = b[1]; hc[6] = b[2]; hc[7] = b[3]; }
        else {
#pragma unroll
            for (int e = 0; e < 8; ++e) hc[e] = 0.f; }
        if (samp) {
#pragma unroll 1
            for (int kb = 0; kb < 32; kb += 8) {
                u32x4 tv[8]; float dec[8]; bf16_t* sp[8];
#pragma unroll
                for (int k2 = 0; k2 < 8; ++k2) { const int k = kb + k2; const int c = d ? 31 - k : k; const int cidx = c0 + c;
                    sp[k2] = S + ((size_t)(cidx * 2 + d) * 16 + h) * 8192 + pn * 8; tv[k2] = *(const u32x4*)sp[k2];
                    dec[k2] = ex2(DTA[(size_t)(cidx * 128 + (d ? 0 : 127)) * 32 + d * 16 + h][1]); }
#pragma unroll
                for (int k2 = 0; k2 < 8; ++k2) {
                    u32x4 o; o.x = pk2(hc[0], hc[1]); o.y = pk2(hc[2], hc[3]); o.z = pk2(hc[4], hc[5]); o.w = pk2(hc[6], hc[7]);
                    *(u32x4*)sp[k2] = o;
                    const u32x4 t = tv[k2]; const float dc = dec[k2];
                    hc[0] = hc[0] * dc + bflo(t.x); hc[1] = hc[1] * dc + bfhi(t.x); hc[2] = hc[2] * dc + bflo(t.y); hc[3] = hc[3] * dc + bfhi(t.y);
                    hc[4] = hc[4] * dc + bflo(t.z); hc[5] = hc[5] * dc + bfhi(t.z); hc[6] = hc[6] * dc + bflo(t.w); hc[7] = hc[7] * dc + bfhi(t.w);
                }
            }
        } else {
            u32x4 tv[2]; float dec[2]; bf16_t* sp[2];
#pragma unroll
            for (int k2 = 0; k2 < 2; ++k2) { const int c = d ? 1 - k2 : k2; const int cidx = c0 + c;
                sp[k2] = S + ((size_t)(cidx * 2 + d) * 16 + h) * 8192 + pn * 8; tv[k2] = *(const u32x4*)sp[k2];
                dec[k2] = ex2(DTA[(size_t)(cidx * 128 + (d ? 0 : 127)) * 32 + d * 16 + h][1]); }
#pragma unroll
            for (int k2 = 0; k2 < 2; ++k2) {
                u32x4 o; o.x = pk2(hc[0], hc[1]); o.y = pk2(hc[2], hc[3]); o.z = pk2(hc[4], hc[5]); o.w = pk2(hc[6], hc[7]);
                *(u32x4*)sp[k2] = o;
                const u32x4 t = tv[k2]; const float dc = dec[k2];
                hc[0] = hc[0] * dc + bflo(t.x); hc[1] = hc[1] * dc + bfhi(t.x); hc[2] = hc[2] * dc + bflo(t.y); hc[3] = hc[3] * dc + bfhi(t.y);
                hc[4] = hc[4] * dc + bflo(t.z); hc[5] = hc[5] * dc + bfhi(t.z); hc[6] = hc[6] * dc + bflo(t.w); hc[7] = hc[7] * dc + bfhi(t.w);
            }
        }
        if (!samp) { float* o = nst + ((size_t)(sq * 2 + d) * 16 + h) * 8192 + pn * 8;
            __builtin_nontemporal_store((f32x4){hc[0], hc[1], hc[2], hc[3]}, (f32x4*)o); __builtin_nontemporal_store((f32x4){hc[4], hc[5], hc[6], hc[7]}, (f32x4*)(o + 4)); }
    }
}

DI void p5_item(const Params& p, LAS unsigned char* lds, int cidx, int g) {
    int tid_ = threadIdx.x; asm volatile("" : "+v"(tid_));
    const int tid = tid_, wid = __builtin_amdgcn_readfirstlane(tid >> 6), lane = tid & 63, i16 = lane & 15, G = lane >> 4;
    const f32x2* DTA = (const f32x2*)(p.ws + OFF_DTA);
    const bf16_t* HS = (const bf16_t*)(p.ws + OFF_S);
    bf16_t* ZG = (bf16_t*)(p.ws + OFF_ZG);
    float* SSQ = (float*)(p.ws + OFF_SSQ);
    const int tok0 = cidx * 128;
    LAS unsigned char* Cimg = lds;
    LAS unsigned char* Ximg = lds + 34816;
    LAS unsigned char* BHimg = lds + 104448;
    LAS float* A2s = (LAS float*)(lds + 139264);
    LAS float* LJs = (LAS float*)(lds + 143360);
    stage_conv<true>(p, cidx, g, Ximg, BHimg, 272, Cimg);
#pragma unroll
    for (int r = 0; r < 2; ++r) { const int j = tid & 127, dhl = (tid >> 7) + 4 * r, d = dhl >> 2, hl = dhl & 3;
        const f32x2 me = DTA[(size_t)(tok0 + j) * 32 + d * 16 + 4 * g + hl];
        A2s[dhl * 128 + j] = me[1]; LJs[dhl * 128 + j] = __builtin_amdgcn_logf(me[0]) - me[1]; }
    __syncthreads();
    u32x4 hreg[4];
    {
#pragma unroll
        for (int itr = 0; itr < 4; ++itr) { const int q = itr * 512 + tid; const int row = q >> 4, cc = q & 15;
            hreg[itr] = *(const u32x4*)(HS + ((size_t)(cidx * 2 + 0) * 16 + 4 * g + 0 + (row >> 6)) * 8192 + (row & 63) * 128 + cc * 8); }
    }
    bf16x8 cf[4];
#pragma unroll
    for (int ks = 0; ks < 4; ++ks) cf[ks] = *(const LAS bf16x8*)(Cimg + (16 * wid + i16) * 272 + (32 * ks + 8 * G) * 2);
    f32x4 cbt[8];
#pragma unroll
    for (int jt = 0; jt < 8; ++jt) { cbt[jt] = (f32x4){0.f, 0.f, 0.f, 0.f};
#pragma unroll
        for (int ks = 0; ks < 4; ++ks) { const bf16x8 bf = *(const LAS bf16x8*)(BHimg + (16 * jt + i16) * 272 + (32 * ks + 8 * G) * 2);
            cbt[jt] = __builtin_amdgcn_mfma_f32_16x16x32_bf16(bf, cf[ks], cbt[jt], 0, 0, 0); }
        asm volatile("" : "+v"(cbt[jt])); if (jt & 1) __builtin_amdgcn_sched_barrier(0); }
    f32x4 Y[4][4];
#pragma unroll
    for (int a = 0; a < 4; ++a)
#pragma unroll
        for (int b = 0; b < 4; ++b) Y[a][b] = (f32x4){0.f, 0.f, 0.f, 0.f};
    __syncthreads();
#pragma unroll 1
    for (int d = 0; d < 2; ++d) {
#pragma unroll
        for (int hp = 0; hp < 2; ++hp) {
#pragma unroll
            for (int itr = 0; itr < 4; ++itr) { const int q = itr * 512 + tid; const int row = q >> 4, cc = q & 15;
                *(LAS u32x4*)(BHimg + row * 272 + cc * 16) = hreg[itr]; }
            if (!(d == 1 && hp == 1)) { const int dn = hp == 1 ? d + 1 : d, hpn = hp == 1 ? 0 : 1;
#pragma unroll
                for (int itr = 0; itr < 4; ++itr) { const int q = itr * 512 + tid; const int row = q >> 4, cc = q & 15;
                    hreg[itr] = *(const u32x4*)(HS + ((size_t)(cidx * 2 + dn) * 16 + 4 * g + 2 * hpn + (row >> 6)) * 8192 + (row & 63) * 128 + cc * 8); } }
            __syncthreads();
#pragma unroll
            for (int hh = 0; hh < 2; ++hh) {
                const int hl = 2 * hp + hh;
                const float ei = ex2(A2s[(d * 4 + hl) * 128 + 16 * wid + i16]);
#pragma unroll
                for (int mt = 0; mt < 4; ++mt) { f32x4 t = (f32x4){0.f, 0.f, 0.f, 0.f};
#pragma unroll
                    for (int ks = 0; ks < 4; ++ks) { const bf16x8 hf = *(const LAS bf16x8*)(BHimg + (hh * 64 + 16 * mt + i16) * 272 + (32 * ks + 8 * G) * 2);
                        t = __builtin_amdgcn_mfma_f32_16x16x32_bf16(hf, cf[ks], t, 0, 0, 0); }
                    Y[hl][mt] += t * ei; if (mt & 1) __builtin_amdgcn_sched_barrier(0); }
            }
            __syncthreads();
        }
    }
    const int tl4 = lane >> 2, c44 = lane & 3;
    bf16_t* zrow4 = ZG + (size_t)(tok0 + 16 * wid + tl4) * DM + g * 256;
    u32x4 zzA[4];
#pragma unroll
    for (int it2 = 0; it2 < 4; ++it2) zzA[it2] = *(const u32x4*)(zrow4 + (c44 + 4 * it2) * 8);
    u32x4 zzB[4];
#pragma unroll
    for (int it2 = 0; it2 < 4; ++it2) zzB[it2] = *(const u32x4*)(zrow4 + (c44 + 4 * (4 + it2)) * 8);
    float penf[4], penb[4];
#pragma unroll
    for (int e = 0; e < 4; ++e) { penf[e] = (4 * G + e <= i16) ? 0.f : -INFINITY; penb[e] = (4 * G + e >= i16) ? 0.f : -INFINITY; }
#pragma unroll 1
    for (int d = 0; d < 2; ++d) {
        float pen[4];
#pragma unroll
        for (int e = 0; e < 4; ++e) pen[e] = d ? penb[e] : penf[e];
#pragma unroll
        for (int hl = 0; hl < 4; ++hl) {
            const float ai = A2s[(d * 4 + hl) * 128 + 16 * wid + i16];
#pragma unroll
            for (int ks = 0; ks < 4; ++ks) {
                const bool need = d == 0 ? (2 * ks <= wid) : (2 * ks + 1 >= wid);
                if (need) {
                    float m[8];
#pragma unroll
                    for (int hf = 0; hf < 2; ++hf) { const int jt = 2 * ks + hf;
                        const bool diag = (jt == wid);
                        const bool incl = d == 0 ? (jt < wid) : (jt > wid);
                        const float tp = incl ? 0.f : -INFINITY;
                        const f32x4 lj = *(const LAS f32x4*)(LJs + (d * 4 + hl) * 128 + 16 * jt + 4 * G);
#pragma unroll
                        for (int e = 0; e < 4; ++e) { const float addp = diag ? pen[e] : tp;
                            m[4 * hf + e] = cbt[jt][e] * ex2(ai + lj[e] + addp); } }
                    u32x4 mm; mm.x = pk2(m[0], m[1]); mm.y = pk2(m[2], m[3]); mm.z = pk2(m[4], m[5]); mm.w = pk2(m[6], m[7]);
                    const bf16x8 mf = u4_as_bf8(mm);
                    const int r0 = 32 * ks + 4 * G + (i16 >> 2);
#pragma unroll
                    for (int mt = 0; mt < 4; ++mt) { const int cb = hl * 64 + 16 * mt + 4 * (i16 & 3);
                        const bf16x8 xf = cat8(trrd(Ximg + r0 * 544 + cb * 2), trrd(Ximg + (r0 + 16) * 544 + cb * 2));
                        Y[hl][mt] = __builtin_amdgcn_mfma_f32_16x16x32_bf16(xf, mf, Y[hl][mt], 0, 0, 0); }
                }
                __builtin_amdgcn_sched_barrier(0);
            }
        }
    }
    {
        LAS unsigned char* T = (wid < 4 ? Cimg : BHimg) + (wid & 3) * 8448;
        const int tl = lane >> 2, c4 = lane & 3;
        const int tok = tok0 + 16 * wid + tl;
        bf16_t* zrow = ZG + (size_t)tok * DM + g * 256;
#pragma unroll
        for (int hl = 0; hl < 4; ++hl) {
            const float dsk = p.in[13][4 * g + hl];
#pragma unroll
            for (int mt = 0; mt < 4; ++mt) { const int chl = hl * 64 + 16 * mt + 4 * G;
                const u32x2 xx = *(const LAS u32x2*)(Ximg + (16 * wid + i16) * 544 + chl * 2);
                u32x2 o; o.x = pk2(Y[hl][mt][0] + bflo(xx.x) * dsk, Y[hl][mt][1] + bfhi(xx.x) * dsk); o.y = pk2(Y[hl][mt][2] + bflo(xx.y) * dsk, Y[hl][mt][3] + bfhi(xx.y) * dsk);
                *(LAS u32x2*)(T + i16 * 528 + chl * 2) = o; }
        }
        float ssq = 0.f;
#pragma unroll
        for (int ih = 0; ih < 2; ++ih) {
#pragma unroll
            for (int it2 = 0; it2 < 4; ++it2) { const int itr = 4 * ih + it2; const u32x4 yy = *(const LAS u32x4*)(T + tl * 528 + (c4 + 4 * itr) * 16); const u32x4 z = ih == 0 ? zzA[it2] : zzB[it2];
                const float y0 = bflo(yy.x) * bflo(z.x), y1 = bfhi(yy.x) * bfhi(z.x), y2 = bflo(yy.y) * bflo(z.y), y3 = bfhi(yy.y) * bfhi(z.y);
                const float y4 = bflo(yy.z) * bflo(z.z), y5 = bfhi(yy.z) * bfhi(z.z), y6 = bflo(yy.w) * bflo(z.w), y7 = bfhi(yy.w) * bfhi(z.w);
                ssq += ((y0 * y0 + y1 * y1) + (y2 * y2 + y3 * y3)) + ((y4 * y4 + y5 * y5) + (y6 * y6 + y7 * y7));
                u32x4 o; o.x = pk2(y0, y1); o.y = pk2(y2, y3); o.z = pk2(y4, y5); o.w = pk2(y6, y7);
                *(u32x4*)(zrow + (c4 + 4 * itr) * 8) = o; }
        }
        ssq += __shfl_xor(ssq, 1); ssq += __shfl_xor(ssq, 2);
        if (c4 == 0) SSQ[(size_t)tok * 4 + g] = ssq;
    }
    __syncthreads();
}

__global__ void __launch_bounds__(512) fwd_megakernel(Params p) {
    extern __shared__ __attribute__((aligned(16))) unsigned char lds_raw[];
    LAS unsigned char* lds = (LAS unsigned char*)lds_raw;
    cg::grid_group grid = cg::this_grid();
    volatile LAS unsigned* xst = (volatile LAS unsigned*)(lds + LDS_WORK);
    if (threadIdx.x == 0) { xst[0] = 0u; xst[1] = 0u; xst[2] = 0u; xst[3] = 0u; }
    __syncthreads();
    (void)xcd_barrier_post((unsigned*)(p.ws + OFF_BAR), xst);
#define XBAR() do { XcdBarrier b_; b_.bar = (unsigned*)(p.ws + OFF_BAR); b_.x = xb_xcc_id(); b_.st = (volatile LAS unsigned*)(lds + LDS_WORK); xcd_barrier(b_); } while (0)
    pg8::StaticOrder so;
    const float* mod = (const float*)(p.ws + OFF_MOD);

#ifndef SKIP_P0
    phase0a(p, lds);
#endif
    if (p.out == nullptr) grid.sync();
    XBAR();
#ifndef SKIP_P1
    phase_norm_mod<0>(p);
#endif
#ifndef SKIP_P0
    {
        const bool defer = gridDim.x == 256;
        phase0b(p, lds, 0, defer ? 8 * 41 : (1 << 20), blockIdx.x, gridDim.x);
    }
#endif
    XBAR();
#ifndef SKIP_G1
    {
        pg8::Gemm g{(const bf16_t*)(p.ws + OFF_HB), (const bf16_t*)(p.ws + OFF_HB), (const bf16_t*)(p.ws + OFF_WIN), 1024, 1024, 16, 16, 1 << 20, 0, 0, nullptr};
        so.init(MT, NIN, gridDim.x, blockIdx.x);
        pg8::EpiInProj e{(bf16_t*)(p.ws + OFF_ZG), (bf16_t*)p.out, (bf16_t*)(p.ws + OFF_U), (bf16_t*)(p.ws + OFF_V), (float*)(p.ws + OFF_DT), (float*)(p.ws + OFF_LNP)};
        pg8::gemm_phase(lds, g, so, e);
    }
#endif
#ifndef SKIP_P0
    if (gridDim.x == 256) phase0b(p, lds, 8 * 41, 1 << 20, (int)blockIdx.x - 144, 112);
#endif
    XBAR();
#ifndef SKIP_P3
    phase3(p, lds);
#endif
    XBAR();
#ifndef SKIP_P4
    phase4(p);
#endif
    XBAR();
#ifndef SKIP_P5
    for (int it = blockIdx.x; it < 640; it += gridDim.x) p5_item(p, lds, it >> 2, it & 3);
    if (gridDim.x == 256 && blockIdx.x >= 128) for (int k = 0; k < 5; ++k) { const int it = 640 + (blockIdx.x - 128) * 5 + k; p3_cmlp_item(p, lds, it >> 3, it & 7); }
#endif
    XBAR();
#ifndef SKIP_G3
    {
        pg8::Gemm g{(const bf16_t*)(p.ws + OFF_ZG), (const bf16_t*)(p.ws + OFF_U), (const bf16_t*)(p.ws + OFF_WOUT), 1024, 2048, 32, 16, 1 << 20, 0, 0, (const float*)(p.ws + OFF_SSQ)};
        pg8::HybridOrder3 ho{(int)gridDim.x, (int)blockIdx.x, (size_t)(OFF_U - OFF_ZG)};
        pg8::EpiPartialQ3 e{mod + 2048, (const float*)(p.ws + OFF_SSQ), (bf16_t*)(p.ws + OFF_P3A), (bf16_t*)(p.ws + OFF_P3B)};
        pg8::gemm_phase(lds, g, ho, e);
    }
#endif
    XBAR();
#ifndef SKIP_P6
    phase_norm_mod<1>(p);
#endif
    XBAR();
#ifndef SKIP_G4
    {
        pg8::Gemm g{(const bf16_t*)(p.ws + OFF_HB), (const bf16_t*)(p.ws + OFF_HB), (const bf16_t*)(p.ws + OFF_WFF1), 1024, 1024, 16, 16, 1 << 20, 0, 0, nullptr};
        so.init(MT, 4096, gridDim.x, blockIdx.x);
        pg8::EpiRelu2 e{(bf16_t*)(p.ws + OFF_F)};
        pg8::gemm_phase(lds, g, so, e);
    }
#endif
    XBAR();
#ifndef SKIP_G5
    {
        pg8::Gemm g{(const bf16_t*)(p.ws + OFF_F), (const bf16_t*)(p.ws + OFF_F), (const bf16_t*)(p.ws + OFF_WFF2), 4096, 4096, 64, 1 << 20, 1 << 20, 0, 0, nullptr};
        pg8::HybridOrder5 ho{(int)gridDim.x, (int)blockIdx.x};
        pg8::EpiPartialQ e{mod + 5120, (bf16_t*)(p.ws + OFF_P5A), (bf16_t*)(p.ws + OFF_P5B)};
        pg8::gemm_phase(lds, g, ho, e);
    }
#endif
    XBAR();
#ifndef SKIP_P7
    phase_final_norm(p);
#endif
}

extern "C" void kernel_launch(void* const* d_in, const int* in_sizes, int n_in, void* d_out, int out_size, void* d_ws, size_t ws_size, hipStream_t stream) {
    static int grid_blocks = 0;
    if (grid_blocks == 0) {
        if (n_in != 24 || ws_size < WS_END) { fprintf(stderr, "kernel_launch: unexpected n_in %d / ws_size %zu (need %zu)\n", n_in, ws_size, (size_t)WS_END); grid_blocks = -1; return; }
        int dev = 0, cus = 0, per_cu = 0;
        hipGetDevice(&dev);
        hipDeviceGetAttribute(&cus, hipDeviceAttributeMultiprocessorCount, dev);
        if (hipFuncSetAttribute((const void*)fwd_megakernel, hipFuncAttributeMaxDynamicSharedMemorySize, LDS_BYTES) != hipSuccess) { fprintf(stderr, "kernel_launch: hipFuncSetAttribute failed\n"); grid_blocks = -1; return; }
        hipOccupancyMaxActiveBlocksPerMultiprocessor(&per_cu, (const void*)fwd_megakernel, 512, LDS_BYTES);
        if (per_cu < 1) per_cu = 1;
        grid_blocks = cus * per_cu;
        (void)hipGetLastError();
    }
    if (grid_blocks < 0) return;
    Params p{};
    for (int i = 0; i < 24; ++i) p.in[i] = (const float*)d_in[i];
    p.out = (float*)d_out; p.ws = (unsigned char*)d_ws;
    if (hipMemsetAsync((char*)d_ws + OFF_BAR, 0, 16384, stream) != hipSuccess) { fprintf(stderr, "kernel_launch: memset failed\n"); return; }
    void* args[] = {&p};
    hipError_t e = hipLaunchCooperativeKernel((const void*)fwd_megakernel, dim3(grid_blocks), dim3(512), args, LDS_BYTES, stream);
    if (e != hipSuccess) fprintf(stderr, "cooperative launch failed: %s (grid %d)\n", hipGetErrorString(e), grid_blocks);
}
```

```cpp
#include <hip/hip_runtime.h>
#include <hip/hip_cooperative_groups.h>
#include <cstdio>
namespace cg = cooperative_groups;

#define LAS __attribute__((address_space(3)))
#define DI __device__ __forceinline__
typedef unsigned short bf16_t;
typedef short bf16x8 __attribute__((ext_vector_type(8)));
typedef short s16x4 __attribute__((ext_vector_type(4)));
typedef float f32x4 __attribute__((ext_vector_type(4)));
typedef float f32x2 __attribute__((ext_vector_type(2)));
typedef unsigned u32x4 __attribute__((ext_vector_type(4)));
typedef unsigned u32x2 __attribute__((ext_vector_type(2)));

constexpr int MT = 20480, NPR = 4096, DM = 1024;
constexpr int NIN = 5376;
constexpr float EPSF = 1e-6f;
constexpr float LOG2E = 1.4426950408889634f;

constexpr size_t OFF_WFF2 = 0;
constexpr size_t OFF_WSB = OFF_WFF2 + (size_t)4096 * 1024 * 2;
constexpr size_t OFF_MOD = OFF_WSB + (size_t)8 * 128 * 128 * 2;
constexpr size_t OFF_PE = OFF_MOD + (size_t)5 * 6144 * 4;
constexpr size_t OFF_SSQ = OFF_PE + (size_t)64 * 512 * 4;
constexpr size_t OFF_BAR = OFF_SSQ + (size_t)MT * 4 * 4;
constexpr size_t OFF_HB = OFF_BAR + 16384;
constexpr size_t OFF_F = OFF_HB + (size_t)MT * 1024 * 2;
constexpr size_t OFF_ZG = OFF_HB + (size_t)MT * 2048 * 2;
constexpr size_t OFF_U = OFF_ZG + (size_t)MT * 1024 * 2;
constexpr size_t OFF_V = OFF_U + (size_t)MT * 1024 * 2;
constexpr size_t OFF_WIN = OFF_V + (size_t)MT * 1024 * 2;
constexpr size_t OFF_WOUT = OFF_WIN + (size_t)NIN * 1024 * 2;
constexpr size_t OFF_WFF1 = OFF_WOUT + (size_t)1024 * 2048 * 2;
constexpr size_t OFF_DT = OFF_WFF1 + (size_t)4096 * 1024 * 2;
constexpr size_t OFF_DTA = OFF_DT + (size_t)MT * 32 * 4;
constexpr size_t WS_END0 = OFF_DTA + (size_t)MT * 32 * 2 * 4;
constexpr size_t OFF_P5A = OFF_WIN;
constexpr size_t OFF_P5B = OFF_HB;
constexpr size_t OFF_S = OFF_HB;
constexpr size_t OFF_P3A = OFF_HB;
constexpr size_t OFF_P3B = OFF_F;
constexpr size_t OFF_LNP = (OFF_P5A + (size_t)MT * 1024 * 2) > WS_END0 ? (OFF_P5A + (size_t)MT * 1024 * 2) : WS_END0;
constexpr size_t WS_END = OFF_LNP + (size_t)MT * 16 * 2 * 4;
static_assert(WS_END <= (size_t)256 * 1024 * 1024, "workspace too large");
static_assert(OFF_F + (size_t)MT * 4096 * 2 == OFF_WIN, "F overlay");
static_assert(OFF_HB % 256 == 0 && OFF_WIN % 256 == 0, "align");

constexpr int LDS_WORK = 151552;
constexpr int LDS_BYTES = LDS_WORK + 16;

struct Params {
    const float* in[24];
    float* out;
    unsigned char* ws;
};

DI unsigned pk2(float lo, float hi) { unsigned r; asm volatile("v_cvt_pk_bf16_f32 %0, %1, %2" : "=v"(r) : "v"(lo), "v"(hi)); return r; }
DI float bflo(unsigned u) { return __uint_as_float(u << 16); }
DI float bfhi(unsigned u) { return __uint_as_float(u & 0xffff0000u); }
DI int otid() { int t = threadIdx.x; asm volatile("" : "+v"(t)); return t; }
DI float wave_sum(float v) {
#pragma unroll
    for (int o = 1; o < 64; o <<= 1) v += __shfl_xor(v, o);
    return v;
}
DI float ex2(float x) { return __builtin_amdgcn_exp2f(x); }
DI float silu_f(float x) { return x * __builtin_amdgcn_rcpf(1.0f + ex2(-x * LOG2E)); }
DI float gelu_f(float x) {
    const float u = x * (1.0f + 0.044715f * x * x) * (2.0f * 0.7978845608028654f * LOG2E);
    return x * __builtin_amdgcn_rcpf(1.0f + ex2(-u));
}
DI f32x2 silu2(f32x2 v) { const f32x2 t = v * (-LOG2E); f32x2 d; d.x = ex2(t.x); d.y = ex2(t.y); d = d + 1.0f; f32x2 r; r.x = __builtin_amdgcn_rcpf(d.x); r.y = __builtin_amdgcn_rcpf(d.y); return v * r; }
DI f32x2 gelu2(f32x2 v) {
    constexpr float C = 2.0f * 0.7978845608028654f * LOG2E;
    const f32x2 w = __builtin_elementwise_fma(v * v, (f32x2){-0.044715f * C, -0.044715f * C}, (f32x2){-C, -C});
    const f32x2 t = v * w; f32x2 d; d.x = ex2(t.x); d.y = ex2(t.y); d = d + 1.0f; f32x2 r; r.x = __builtin_amdgcn_rcpf(d.x); r.y = __builtin_amdgcn_rcpf(d.y); return v * r;
}
DI const float* xrow_ptr(const Params& p, int tok) { return tok < NPR ? p.in[0] + (size_t)tok * DM : p.in[1] + (size_t)(tok - NPR) * DM; }
DI int cond_of(int tok) { return tok < NPR ? 0 : 1 + ((tok - NPR) >> 12); }
DI s16x4 trrd(LAS unsigned char* a) { return __builtin_amdgcn_ds_read_tr16_b64_v4i16((LAS s16x4*)a); }
DI bf16x8 cat8(s16x4 a, s16x4 b) { bf16x8 r = {a[0], a[1], a[2], a[3], b[0], b[1], b[2], b[3]}; return r; }
DI bf16x8 u4_as_bf8(u32x4 v) { return __builtin_bit_cast(bf16x8, v); }


#define XB_TMO      128
#define XB_XCNT(j)  (256  + 64 * (j))
#define XB_XSUB(j)  (1280 + 64 * (j))
#define XB_XGEN(j)  (2304 + 64 * (j))
#define XB_TOP      3328
#define XB_TOPGEN   3392
#define XCD_BAR_WORDS 3456
#define XB_SPIN_CAP (1u << 20)
DI unsigned xb_ld(unsigned* p)              { return __hip_atomic_load(p, __ATOMIC_RELAXED, __HIP_MEMORY_SCOPE_AGENT); }
DI unsigned xb_add(unsigned* p, unsigned v) { return __hip_atomic_fetch_add(p, v, __ATOMIC_RELAXED, __HIP_MEMORY_SCOPE_AGENT); }
DI unsigned xb_xcc_id() { return (unsigned)__builtin_amdgcn_s_getreg((3 << 11) | 20) & 0xFu; }
#define XB_SPIN(cond, bar) do { unsigned _sp = 0; while (cond) { __builtin_amdgcn_s_sleep(1); \
    if ((++_sp & 255u) == 0u) { if (xb_ld(&(bar)[XB_TMO])) break; if (_sp > XB_SPIN_CAP) { atomicAdd(&(bar)[XB_TMO], 1u); break; } } } } while (0)
struct XcdBarrier { unsigned* bar; unsigned x; volatile LAS unsigned* st; };
DI XcdBarrier xcd_barrier_post(unsigned* bar, volatile LAS unsigned* st) {
    XcdBarrier b; b.bar = bar; b.x = xb_xcc_id(); b.st = st;
    if (threadIdx.x == 0) (void)xb_add(&bar[XB_XCNT(b.x)], 1u);
    return b;
}
DI void xcd_barrier_complete(unsigned* bar, unsigned x, unsigned& nloc, unsigned& nx) {
    const unsigned G = gridDim.x * gridDim.y * gridDim.z;
    unsigned sum, cnt, mine, sp = 0u;
    for (;;) {
        sum = 0u; cnt = 0u; mine = 0u;
#pragma unroll
        for (unsigned j = 0; j < 16; ++j) { const unsigned c = xb_ld(&bar[XB_XCNT(j)]); sum += c; cnt += (c > 0u) ? 1u : 0u; mine = (j == x) ? c : mine; }
        if (sum == G) break;
        __builtin_amdgcn_s_sleep(1);
        if ((++sp & 255u) == 0u) { if (xb_ld(&bar[XB_TMO])) break; if (sp > XB_SPIN_CAP) { atomicAdd(&bar[XB_TMO], 1u); break; } }
    }
    nloc = mine > 0u ? mine : 1u; nx = cnt > 0u ? cnt : 1u;
}
DI void xcd_barrier(const XcdBarrier& b) {
    asm volatile("s_waitcnt vmcnt(0)" ::: "memory");
    __syncthreads();
    if (threadIdx.x == 0) {
        unsigned* bar = b.bar;
        __builtin_amdgcn_s_waitcnt(0);
        unsigned nloc = b.st[0], nx = b.st[1];
        if (nloc == 0u) { xcd_barrier_complete(bar, b.x, nloc, nx); b.st[0] = nloc; b.st[1] = nx; }
        const unsigned old = xb_add(&bar[XB_XSUB(b.x)], 1u);
        const unsigned gen = old / nloc;
        if (old + 1u == (gen + 1u) * nloc) {
            __builtin_amdgcn_fence(__ATOMIC_RELEASE, "agent");
            asm volatile("s_waitcnt vmcnt(0)" ::: "memory");
            const unsigned og = xb_add(&bar[XB_TOP], 1u);
            const unsigned tg = og / nx;
            if (og + 1u == (tg + 1u) * nx) xb_add(&bar[XB_TOPGEN], 1u);
            else XB_SPIN(xb_ld(&bar[XB_TOPGEN]) == tg, bar);
            __builtin_amdgcn_fence(__ATOMIC_ACQUIRE, "agent");
            xb_add(&bar[XB_XGEN(b.x)], 1u);
            asm volatile("s_waitcnt vmcnt(0)" ::: "memory");
        } else {
            XB_SPIN(xb_ld(&bar[XB_XGEN(b.x)]) == gen, bar);
            __builtin_amdgcn_fence(__ATOMIC_ACQUIRE, "agent");
            asm volatile("s_waitcnt vmcnt(0)" ::: "memory");
        }
    }
    __syncthreads();
}

namespace pg8 {
constexpr int BM = 256, BK = 64, HALF = 128, HTB = HALF * BK * 2, STAGE_BYTES = 8 * HTB, NXCD = 8, WGM = 8;
DI int lds_byte(int r, int c) { const int st = (r >> 4) * 2 + (c >> 5), rr = r & 15, cc = c & 31, ob = rr * 64 + cc * 2; return st * 1024 + (ob ^ (((ob >> 9) & 1) << 5)); }
DI void stage_rc(int b, int& R, int& C) { const int st = b / 1024, sb = b % 1024, swz = sb ^ (((sb >> 9) & 1) << 5); R = (st >> 1) * 16 + swz / 64; C = (st & 1) * 32 + (swz % 64) / 2; }
DI int perm32(int rho) { const int n = rho >> 4, i = rho & 15; return 8 * (i >> 2) + 4 * n + (i & 3); }
struct Unit { int pm, pn, kh, nt; size_t koffA, koffB; };
struct Gemm { const bf16_t* A; const bf16_t* A2; const bf16_t* Bt; int lda, ldb, nt, ksplit, nnr; size_t koffA, koffB; const float* ssq; };
struct StaticOrder {
    static constexpr bool CUSTOM = false;
    int nM, nN, nwg, G, c;
    DI void init(int M, int N, int G_, int c_) { nM = M / BM; nN = N / BM; nwg = nM * nN; G = G_; c = c_; }
    DI bool next(int i, Unit& u) const {
        const long L = (long)i * G + c; if (L >= nwg) return false;
        int wgid = (int)L; { const int q = nwg / NXCD, r = nwg % NXCD, xcd = wgid % NXCD, off = wgid / NXCD; wgid = (xcd < r ? xcd * (q + 1) : r * (q + 1) + (xcd - r) * q) + off; }
        const int nig = WGM * nN, gid = wgid / nig, fm = gid * WGM, gsz = (nM - fm) < WGM ? (nM - fm) : WGM;
        u.pm = fm + ((wgid % nig) % gsz); u.pn = (wgid % nig) / gsz; return true;
    }
};

struct HybridOrder5 {
    static constexpr bool CUSTOM = true;
    int G, c;
    DI bool next(int i, Unit& u) const {
        const int id = i * G + c; if (id >= 512) return false;
        const int x = id & 7, j = (id & 255) >> 3;
        if (id < 256) { u.pm = 8 * x + (j & 7); u.pn = j >> 3; u.kh = 0; u.nt = 64; u.koffA = 0; u.koffB = 0; }
        else { const int kq = j >> 3; u.pm = 64 + 2 * x + (j & 1); u.pn = (j >> 1) & 3; u.kh = kq; u.nt = 16; u.koffA = (size_t)kq * 1024 * 2; u.koffB = (size_t)kq * 1024 * 2; }
        return true;
    }
};
struct HybridOrder3 {
    static constexpr bool CUSTOM = true;
    int G, c; size_t uoff;
    DI bool next(int i, Unit& u) const {
        const int id = i * G + c; if (id >= 512) return false;
        const int x = id & 7, j = (id & 255) >> 3;
        if (id < 256) { u.pm = 8 * x + (j & 7); u.pn = j >> 3; u.kh = 0; u.nt = 32; u.koffA = 0; u.koffB = 0; }
        else { const int kq = j >> 3; u.pm = 64 + 2 * x + (j & 1); u.pn = (j >> 1) & 3; u.kh = kq; u.nt = 8; u.koffA = (kq >= 2 ? uoff : (size_t)0) + (size_t)(kq & 1) * 512 * 2; u.koffB = (size_t)kq * 512 * 2; }
        return true;
    }
};

template <class Epi, class Sched>
DI void gemm_phase(LAS unsigned char* lds, const Gemm g, const Sched& S, const Epi& E) {
    int tid_ = threadIdx.x; asm volatile("" : "+v"(tid_));
    const int tid = tid_, wid = __builtin_amdgcn_readfirstlane(tid >> 6), lane = tid & 63, wr = wid >> 2, wc = wid & 3, fr = lane & 15, fq = lane >> 4;
    const int K = g.ldb, lda = g.lda, ksp = g.ksplit;
    unsigned voffA[2], voffB[2];
#pragma unroll
    for (int i = 0; i < 2; ++i) { int R, C; stage_rc(tid * 16 + i * 8192, R, C); const int Rb = Epi::PERM ? ((R & ~31) + perm32(R & 31)) : R;
        voffA[i] = (unsigned)(R * lda + C) * 2u; voffB[i] = (unsigned)(Rb * K + C) * 2u; }
    const size_t kstep = (size_t)(BK * 2);
    const size_t hstepA = (size_t)HALF * lda * 2, hstepB = (size_t)HALF * K * 2;
    const size_t tstepA = 2 * hstepA, tstepB = 2 * hstepB;
    const unsigned ldsw = (unsigned)wid * 1024u;
    const int aoff = lds_byte(wr * 64 + fr, fq * 8), boff = lds_byte(wc * 32 + fr, fq * 8);
#define PG8_SA(b, h) (((b) * 2 + (h)) * HTB)
#define PG8_SB(b, h) ((4 + (b) * 2 + (h)) * HTB)
#define PG8_STAGE(bufoff, gbase, voff) do { _Pragma("unroll") for (int _i = 0; _i < 2; ++_i) \
        __builtin_amdgcn_global_load_lds((const unsigned*)((const char*)(gbase) + (voff)[_i]), (LAS unsigned*)(lds + (bufoff) + ldsw + _i * 8192), 16, 0, 0); } while (0)
#define PG8_LDA(dst, b, h) do { _Pragma("unroll") for (int m = 0; m < 4; ++m) _Pragma("unroll") for (int k = 0; k < 2; ++k) dst[m][k] = *(const LAS bf16x8*)(lds + PG8_SA(b, h) + aoff + m * 2048 + k * 1024); } while (0)
#define PG8_LDB(dst, b, h) do { _Pragma("unroll") for (int n = 0; n < 2; ++n) _Pragma("unroll") for (int k = 0; k < 2; ++k) dst[n][k] = *(const LAS bf16x8*)(lds + PG8_SB(b, h) + boff + n * 2048 + k * 1024); } while (0)
#define PG8_MMA(ai, bj, At, Bt) do { __builtin_amdgcn_s_setprio(1); _Pragma("unroll") for (int m = 0; m < 4; ++m) _Pragma("unroll") for (int n = 0; n < 2; ++n) _Pragma("unroll") for (int k = 0; k < 2; ++k) \
        acc[ai][bj][m][n] = __builtin_amdgcn_mfma_f32_16x16x32_bf16(Bt[n][k], At[m][k], acc[ai][bj][m][n], 0, 0, 0); __builtin_amdgcn_s_setprio(0); } while (0)
#define PG8_WAIT_V(n) asm volatile("s_waitcnt vmcnt(" #n ")" ::: "memory")
#define PG8_WAIT_L(n) asm volatile("s_waitcnt lgkmcnt(" #n ")" ::: "memory")
#define PG8_BAR __builtin_amdgcn_s_barrier()
#define PG8_SCHED __builtin_amdgcn_sched_barrier(0)
#define PG8_APTR(b1, b2, t) ((t) < ksp ? (b1) + (size_t)(t) * kstep : (b2) + (size_t)((t) - ksp) * kstep)
    Unit cur, nxt; int ui = 0;
    if (!S.next(0, cur)) return;
    if constexpr (!Sched::CUSTOM) { cur.kh = cur.pn / g.nnr; cur.pn -= cur.kh * g.nnr; cur.nt = g.nt; cur.koffA = (size_t)cur.kh * g.koffA; cur.koffB = (size_t)cur.kh * g.koffB; }
    int nt = cur.nt;
    f32x4 acc[2][2][4][2];
#pragma unroll
    for (int a = 0; a < 2; ++a)
#pragma unroll
        for (int b = 0; b < 2; ++b)
#pragma unroll
            for (int m = 0; m < 4; ++m)
#pragma unroll
                for (int n = 0; n < 2; ++n) acc[a][b][m][n] = (f32x4){0.f, 0.f, 0.f, 0.f};
    bf16x8 At[4][2], B0[2][2], B1[2][2];
    const char* cA = (const char*)g.A + (size_t)cur.pm * tstepA + cur.koffA; const char* cA2 = (const char*)g.A2 + (size_t)cur.pm * tstepA;
    const char* cB = (const char*)g.Bt + (size_t)cur.pn * tstepB + cur.koffB;
    PG8_STAGE(PG8_SB(0, 0), cB, voffB); PG8_STAGE(PG8_SA(0, 0), cA, voffA); PG8_STAGE(PG8_SB(0, 1), cB + hstepB, voffB); PG8_STAGE(PG8_SA(0, 1), cA + hstepA, voffA);
    if (wr == 1) PG8_BAR;
    PG8_WAIT_V(4); PG8_BAR;
    PG8_STAGE(PG8_SB(1, 0), cB + kstep, voffB); PG8_STAGE(PG8_SA(1, 0), cA + kstep, voffA); PG8_STAGE(PG8_SB(1, 1), cB + hstepB + kstep, voffB);
    PG8_WAIT_V(6); PG8_BAR;
    for (;;) {
        const bool has_next = S.next(ui + 1, nxt);
        if constexpr (!Sched::CUSTOM) { if (has_next) { nxt.kh = nxt.pn / g.nnr; nxt.pn -= nxt.kh * g.nnr; nxt.nt = g.nt; nxt.koffA = (size_t)nxt.kh * g.koffA; nxt.koffB = (size_t)nxt.kh * g.koffB; } }
        const char* nA = has_next ? (const char*)g.A + (size_t)nxt.pm * tstepA + nxt.koffA : cA; const char* nB = has_next ? (const char*)g.Bt + (size_t)nxt.pn * tstepB + nxt.koffB : cB;
        for (int t = 0; t < nt; t += 2) {
            const bool last = (t == nt - 2);
            const char* a1 = PG8_APTR(cA, cA2, t + 1);
            const char* a2 = last ? nA : PG8_APTR(cA, cA2, t + 2); const char* b2 = last ? nB : cB + (size_t)(t + 2) * kstep;
            const char* a3 = a2 + kstep; const char* b3 = b2 + kstep;
            if constexpr (Epi::MIDSCALE) {
                if (t == ksp) {
#pragma unroll
                    for (int ai = 0; ai < 2; ++ai)
#pragma unroll
                        for (int m = 0; m < 4; ++m) {
                            const int row = cur.pm * BM + ai * HALF + wr * 64 + m * 16 + fr;
                            const f32x4 s4 = *(const f32x4*)(g.ssq + (size_t)row * 4);
                            const float rs = __builtin_amdgcn_rsqf(((s4[0] + s4[1]) + (s4[2] + s4[3])) * (1.0f / 1024.0f) + EPSF);
#pragma unroll
                            for (int bj = 0; bj < 2; ++bj)
#pragma unroll
                                for (int n = 0; n < 2; ++n) acc[ai][bj][m][n] *= rs;
                            if (m & 1) asm volatile("" ::: "memory");
                        }
                }
            }
            PG8_LDB(B0, 0, 0); PG8_SCHED; PG8_LDA(At, 0, 0); PG8_STAGE(PG8_SA(1, 1), a1 + hstepA, voffA);
            PG8_WAIT_L(8); PG8_BAR; PG8_WAIT_L(0); PG8_MMA(0, 0, At, B0); PG8_BAR; PG8_SCHED;
            PG8_LDB(B1, 0, 1); PG8_STAGE(PG8_SB(0, 0), b2, voffB);
            PG8_BAR; PG8_WAIT_L(0); PG8_MMA(0, 1, At, B1); PG8_BAR;
            PG8_LDA(At, 0, 1); PG8_STAGE(PG8_SA(0, 0), a2, voffA);
            PG8_BAR; PG8_WAIT_L(0); PG8_MMA(1, 0, At, B0); PG8_BAR; PG8_SCHED;
            PG8_STAGE(PG8_SB(0, 1), b2 + hstepB, voffB);
            PG8_WAIT_V(6); PG8_BAR; PG8_MMA(1, 1, At, B1); PG8_BAR;
            PG8_LDB(B0, 1, 0); PG8_SCHED; PG8_LDA(At, 1, 0); PG8_STAGE(PG8_SA(0, 1), a2 + hstepA, voffA);
            PG8_WAIT_L(8); PG8_BAR; PG8_WAIT_L(0); PG8_MMA(0, 0, At, B0); PG8_BAR; PG8_SCHED;
            PG8_LDB(B1, 1, 1); PG8_STAGE(PG8_SB(1, 0), b3, voffB);
            PG8_BAR; PG8_WAIT_L(0); PG8_MMA(0, 1, At, B1); PG8_BAR;
            PG8_LDA(At, 1, 1); PG8_STAGE(PG8_SA(1, 0), a3, voffA);
            PG8_BAR; PG8_WAIT_L(0); PG8_MMA(1, 0, At, B0); PG8_BAR; PG8_SCHED;
            PG8_STAGE(PG8_SB(1, 1), b3 + hstepB, voffB);
            PG8_WAIT_V(6); PG8_BAR; PG8_MMA(1, 1, At, B1); PG8_BAR;
        }
        E(acc, cur, wr, wc, fr, fq);
        if (!has_next) break;
#pragma unroll
        for (int a = 0; a < 2; ++a)
#pragma unroll
            for (int b = 0; b < 2; ++b)
#pragma unroll
                for (int m = 0; m < 4; ++m)
#pragma unroll
                    for (int n = 0; n < 2; ++n) acc[a][b][m][n] = (f32x4){0.f, 0.f, 0.f, 0.f};
        cur = nxt; nt = cur.nt; cA = nA; cA2 = (const char*)g.A2 + (size_t)cur.pm * tstepA; cB = nB; ++ui;
    }
    PG8_WAIT_V(0);
    if (wr == 0) PG8_BAR;
    PG8_BAR;
#undef PG8_SA
#undef PG8_SB
#undef PG8_STAGE
#undef PG8_LDA
#undef PG8_LDB
#undef PG8_MMA
#undef PG8_WAIT_V
#undef PG8_WAIT_L
#undef PG8_BAR
#undef PG8_SCHED
#undef PG8_APTR
}

struct EpiInProj {
    static constexpr bool PERM = true, MIDSCALE = false;
    bf16_t *ZG, *XBC, *U, *V; float* DT; float* LNP;
    DI void operator()(const f32x4 (&acc)[2][2][4][2], const Unit& u, int wr, int wc, int fr, int fq) const {
        const int row0 = u.pm * BM + wr * 64 + fr;
        const int pn = u.pn;
        if (pn == 20) {
            if (wc == 0) {
#pragma unroll
                for (int ai = 0; ai < 2; ++ai)
#pragma unroll
                    for (int m = 0; m < 4; ++m) { float* rp = DT + (size_t)(row0 + ai * HALF + m * 16) * 32 + 8 * fq;
                        *(f32x4*)(rp) = acc[ai][0][m][0]; *(f32x4*)(rp + 4) = acc[ai][0][m][1]; }
            }
            return;
        }
        bf16_t* base; int colt, ldc, act;
        if (pn < 4) { base = ZG; colt = pn * 256; ldc = 1024; act = 1; }
        else if (pn < 12) { base = XBC; colt = (pn - 4) * 256; ldc = 2048; act = 0; }
        else if (pn < 16) { base = U; colt = (pn - 12) * 256; ldc = 1024; act = 2; }
        else { base = V; colt = (pn - 16) * 256; ldc = 1024; act = 2; }
        const int col0 = colt + wc * 32 + 8 * fq;
        const bool stats = pn >= 16;
#pragma unroll
        for (int ai = 0; ai < 2; ++ai)
#pragma unroll
            for (int m = 0; m < 4; ++m) { bf16_t* rowp = base + (size_t)(row0 + ai * HALF + m * 16) * ldc + col0;
                float s1 = 0.f, s2 = 0.f;
#pragma unroll
                for (int bj = 0; bj < 2; ++bj) { f32x4 v0 = acc[ai][bj][m][0], v1 = acc[ai][bj][m][1];
                    if (act == 1) { const f32x2 a = silu2((f32x2){v0[0], v0[1]}), b = silu2((f32x2){v0[2], v0[3]}), c = silu2((f32x2){v1[0], v1[1]}), d = silu2((f32x2){v1[2], v1[3]});
                        v0 = (f32x4){a.x, a.y, b.x, b.y}; v1 = (f32x4){c.x, c.y, d.x, d.y}; }
                    else if (act == 2) { const f32x2 a = gelu2((f32x2){v0[0], v0[1]}), b = gelu2((f32x2){v0[2], v0[3]}), c = gelu2((f32x2){v1[0], v1[1]}), d = gelu2((f32x2){v1[2], v1[3]});
                        v0 = (f32x4){a.x, a.y, b.x, b.y}; v1 = (f32x4){c.x, c.y, d.x, d.y}; }
                    if (stats) {
#pragma unroll
                        for (int j = 0; j < 4; ++j) { s1 += v0[j] + v1[j]; s2 += v0[j] * v0[j] + v1[j] * v1[j]; } }
                    u32x4 w; w.x = pk2(v0[0], v0[1]); w.y = pk2(v0[2], v0[3]); w.z = pk2(v1[0], v1[1]); w.w = pk2(v1[2], v1[3]);
                    *(u32x4*)(rowp + bj * HALF) = w; }
                if (stats) { s1 += __shfl_xor(s1, 16); s1 += __shfl_xor(s1, 32); s2 += __shfl_xor(s2, 16); s2 += __shfl_xor(s2, 32);
                    if (fq == 0) *(f32x2*)(LNP + ((size_t)(row0 + ai * HALF + m * 16) * 16 + (pn - 16) * 4 + wc) * 2) = (f32x2){s1, s2}; } }
    }
};
struct EpiRelu2 {
    static constexpr bool PERM = true, MIDSCALE = false;
    bf16_t* F;
    DI void operator()(const f32x4 (&acc)[2][2][4][2], const Unit& u, int wr, int wc, int fr, int fq) const {
        const int row0 = u.pm * BM + wr * 64 + fr, col0 = u.pn * BM + wc * 32 + 8 * fq;
#pragma unroll
        for (int ai = 0; ai < 2; ++ai)
#pragma unroll
            for (int m = 0; m < 4; ++m) { bf16_t* rowp = F + (size_t)(row0 + ai * HALF + m * 16) * 4096 + col0;
#pragma unroll
                for (int bj = 0; bj < 2; ++bj) { f32x4 v0 = acc[ai][bj][m][0], v1 = acc[ai][bj][m][1];
#pragma unroll
                    for (int j = 0; j < 4; ++j) { const float a = fmaxf(v0[j], 0.f), b = fmaxf(v1[j], 0.f); v0[j] = a * a; v1[j] = b * b; }
                    u32x4 w; w.x = pk2(v0[0], v0[1]); w.y = pk2(v0[2], v0[3]); w.z = pk2(v1[0], v1[1]); w.w = pk2(v1[2], v1[3]);
                    *(u32x4*)(rowp + bj * HALF) = w; } }
    }
};
struct EpiPartial {
    static constexpr bool PERM = true, MIDSCALE = false;
    const float* gate; const float* ssq; bf16_t* P0; bf16_t* P1;
    DI void operator()(const f32x4 (&acc)[2][2][4][2], const Unit& u, int wr, int wc, int fr, int fq) const {
        const int row0 = u.pm * BM + wr * 64 + fr, col0 = u.pn * BM + wc * 32 + 8 * fq;
        const float* gp = gate + (size_t)cond_of(u.pm * BM) * 6144 + col0;
        f32x4 gv[2][2];
#pragma unroll
        for (int bj = 0; bj < 2; ++bj)
#pragma unroll
            for (int n = 0; n < 2; ++n) gv[bj][n] = *(const f32x4*)(gp + bj * HALF + n * 4);
        bf16_t* P = u.kh ? P1 : P0;
        const bool scale = (u.kh == 0) && (ssq != nullptr);
#pragma unroll
        for (int ai = 0; ai < 2; ++ai)
#pragma unroll
            for (int m = 0; m < 4; ++m) { const int row = row0 + ai * HALF + m * 16; bf16_t* op = P + (size_t)row * DM + col0;
                float rs = 1.0f;
                if (scale) { const f32x4 s4 = *(const f32x4*)(ssq + (size_t)row * 4); rs = __builtin_amdgcn_rsqf(((s4[0] + s4[1]) + (s4[2] + s4[3])) * (1.0f / 1024.0f) + EPSF); }
#pragma unroll
                for (int bj = 0; bj < 2; ++bj) { const f32x4 v0 = gv[bj][0] * acc[ai][bj][m][0] * rs, v1 = gv[bj][1] * acc[ai][bj][m][1] * rs;
                    u32x4 w; w.x = pk2(v0[0], v0[1]); w.y = pk2(v0[2], v0[3]); w.z = pk2(v1[0], v1[1]); w.w = pk2(v1[2], v1[3]);
                    *(u32x4*)(op + bj * HALF) = w; } }
    }
};
struct EpiPartialQ3 {
    static constexpr bool PERM = true, MIDSCALE = true;
    const float* gate; const float* ssq; bf16_t* PA; bf16_t* PQ;
    DI void operator()(const f32x4 (&acc)[2][2][4][2], const Unit& u, int wr, int wc, int fr, int fq) const {
        const int row0 = u.pm * BM + wr * 64 + fr, col0 = u.pn * BM + wc * 32 + 8 * fq;
        const float* gp = gate + (size_t)cond_of(u.pm * BM) * 6144 + col0;
        f32x4 gv[2][2];
#pragma unroll
        for (int bj = 0; bj < 2; ++bj)
#pragma unroll
            for (int n = 0; n < 2; ++n) gv[bj][n] = *(const f32x4*)(gp + bj * HALF + n * 4);
        bf16_t* base = u.kh == 0 ? PA : PQ + ((size_t)(u.kh - 1) * 4096 - 16384) * DM;
        const bool scale = (u.nt != 32) && (u.kh < 2);
#pragma unroll
        for (int ai = 0; ai < 2; ++ai)
#pragma unroll
            for (int m = 0; m < 4; ++m) { const int row = row0 + ai * HALF + m * 16; bf16_t* op = base + (size_t)row * DM + col0;
                float rs = 1.0f;
                if (scale) { const f32x4 s4 = *(const f32x4*)(ssq + (size_t)row * 4); rs = __builtin_amdgcn_rsqf(((s4[0] + s4[1]) + (s4[2] + s4[3])) * (1.0f / 1024.0f) + EPSF); }
#pragma unroll
                for (int bj = 0; bj < 2; ++bj) { const f32x4 v0 = gv[bj][0] * acc[ai][bj][m][0] * rs, v1 = gv[bj][1] * acc[ai][bj][m][1] * rs;
                    u32x4 w; w.x = pk2(v0[0], v0[1]); w.y = pk2(v0[2], v0[3]); w.z = pk2(v1[0], v1[1]); w.w = pk2(v1[2], v1[3]);
                    *(u32x4*)(op + bj * HALF) = w; } }
    }
};
struct EpiPartialQ {
    static constexpr bool PERM = true, MIDSCALE = false;
    const float* gate; bf16_t* PA; bf16_t* PQ;
    DI void operator()(const f32x4 (&acc)[2][2][4][2], const Unit& u, int wr, int wc, int fr, int fq) const {
        const int row0 = u.pm * BM + wr * 64 + fr, col0 = u.pn * BM + wc * 32 + 8 * fq;
        const float* gp = gate + (size_t)cond_of(u.pm * BM) * 6144 + col0;
        f32x4 gv[2][2];
#pragma unroll
        for (int bj = 0; bj < 2; ++bj)
#pragma unroll
            for (int n = 0; n < 2; ++n) gv[bj][n] = *(const f32x4*)(gp + bj * HALF + n * 4);
        bf16_t* base = u.kh == 0 ? PA : PQ + ((size_t)(u.kh - 1) * 4096 - 16384) * DM;
#pragma unroll
        for (int ai = 0; ai < 2; ++ai)
#pragma unroll
            for (int m = 0; m < 4; ++m) { const int row = row0 + ai * HALF + m * 16; bf16_t* op = base + (size_t)row * DM + col0;
#pragma unroll
                for (int bj = 0; bj < 2; ++bj) { const f32x4 v0 = gv[bj][0] * acc[ai][bj][m][0], v1 = gv[bj][1] * acc[ai][bj][m][1];
                    u32x4 w; w.x = pk2(v0[0], v0[1]); w.y = pk2(v0[2], v0[3]); w.z = pk2(v1[0], v1[1]); w.w = pk2(v1[2], v1[3]);
                    *(u32x4*)(op + bj * HALF) = w; } }
    }
};
template <bool FROM_X, bool MS> struct EpiResid {
    static constexpr bool PERM = false, MIDSCALE = MS;
    const float* xp; const float* xs; const float* pe; const float* gate;
    float* out; bf16_t* Pb;
    DI void operator()(const f32x4 (&acc)[2][2][4][2], const Unit& u, int wr, int wc, int fr, int fq) const {
        const int row0 = u.pm * BM + wr * 64 + fr, col0 = u.pn * BM + wc * 32 + 4 * fq;
        const int tok0 = u.pm * BM;
        const float* gp = gate + (size_t)cond_of(tok0) * 6144 + col0;
        f32x4 gv[2][2];
#pragma unroll
        for (int bj = 0; bj < 2; ++bj)
#pragma unroll
            for (int n = 0; n < 2; ++n) gv[bj][n] = *(const f32x4*)(gp + bj * HALF + n * 16);
        if (u.kh != 0) {
#pragma unroll
            for (int ai = 0; ai < 2; ++ai)
#pragma unroll
                for (int m = 0; m < 4; ++m) { bf16_t* op = Pb + (size_t)(row0 + ai * HALF + m * 16) * DM + col0;
#pragma unroll
                    for (int bj = 0; bj < 2; ++bj)
#pragma unroll
                        for (int n = 0; n < 2; ++n) { const f32x4 v = gv[bj][n] * acc[ai][bj][m][n]; u32x2 o; o.x = pk2(v[0], v[1]); o.y = pk2(v[2], v[3]); *(u32x2*)(op + bj * HALF + n * 16) = o; } }
            return;
        }
#pragma unroll
        for (int ai = 0; ai < 2; ++ai)
#pragma unroll
            for (int m = 0; m < 4; ++m) { const int row = row0 + ai * HALF + m * 16; float* op = out + (size_t)row * DM + col0;
                const float* bp; const float* pp = nullptr;
                if (FROM_X) { bp = (row < NPR ? xp + (size_t)row * DM : xs + (size_t)(row - NPR) * DM) + col0;
                    if (row >= NPR) { const int pos = (row - NPR) & 4095; const int pr = (col0 < 512) ? (pos >> 6) : (pos & 63); pp = pe + pr * 512 + (col0 & 511); } }
                else bp = op;
#pragma unroll
                for (int bj = 0; bj < 2; ++bj)
#pragma unroll
                    for (int n = 0; n < 2; ++n) { f32x4 b = *(const f32x4*)(bp + bj * HALF + n * 16);
                        if (FROM_X) { if (pp) b += *(const f32x4*)(pp + bj * HALF + n * 16); }
                        *(f32x4*)(op + bj * HALF + n * 16) = b + gv[bj][n] * acc[ai][bj][m][n]; }
                asm volatile("" ::: "memory"); }
    }
};
}

DI void p0_ada_item(const Params& p, LAS unsigned char* lds, int item) {
    LAS float* sc = (LAS float*)lds;
    LAS float* red = (LAS float*)(lds + 20480);
    const int tid = otid(), wid = tid >> 6, lane = tid & 63;
    for (int i = tid; i < 5 * 1024; i += 512) { const int c = i >> 10, k = i & 1023; const float v = c == 0 ? p.in[4][k] : p.in[3][(c - 1) * 1024 + k]; sc[i] = silu_f(v); }
    __syncthreads();
    const int kk = lane >> 4, c4 = lane & 15, k0 = wid * 128;
    const float* W = p.in[5] + (size_t)(k0 + kk) * 6144 + item * 64 + c4 * 4;
    f32x4 a[5];
#pragma unroll
    for (int c = 0; c < 5; ++c) a[c] = (f32x4){0.f, 0.f, 0.f, 0.f};
#pragma unroll 8
    for (int i = 0; i < 32; ++i) { const f32x4 w = __builtin_nontemporal_load((const f32x4*)(W + (size_t)i * 4 * 6144)); const int k = k0 + 4 * i + kk;
#pragma unroll
        for (int c = 0; c < 5; ++c) a[c] += w * sc[c * 1024 + k]; }
#pragma unroll
    for (int c = 0; c < 5; ++c)
#pragma unroll
        for (int e = 0; e < 4; ++e) { float v = a[c][e]; v += __shfl_xor(v, 16); v += __shfl_xor(v, 32); a[c][e] = v; }
    if (kk == 0) {
#pragma unroll
        for (int c = 0; c < 5; ++c) *(LAS f32x4*)(red + (wid * 5 + c) * 64 + c4 * 4) = a[c]; }
    __syncthreads();
    if (tid < 320) { const int c = tid >> 6, l = tid & 63; float sum = 0.f;
#pragma unroll
        for (int w = 0; w < 8; ++w) sum += red[(w * 5 + c) * 64 + l];
        const int cc = item * 64 + l;
        ((float*)(p.ws + OFF_MOD))[c * 6144 + cc] = sum + p.in[6][cc]; }
    __syncthreads();
}
DI int win_rowmap(int n0) {
    if (n0 < 3072) return n0;
    if (n0 < 3104) return 5120 + (n0 - 3072);
    if (n0 < 4128) return 3072 + (n0 - 3104);
    return 4096 + (n0 - 4128);
}
template <int NB, bool WINMAP> DI void p0_tr_item(const float* W, int K, int N, bf16_t* WT, int kb, int nb0, int nbmax, const float* kscale, LAS unsigned char* lds) {
    LAS float* t = (LAS float*)lds;
    const int tid = otid();
    const int k0 = kb * 128;
    f32x4 v[NB][2];
#pragma unroll
    for (int b = 0; b < NB; ++b) { const int nb = nb0 + b;
#pragma unroll
        for (int ps = 0; ps < 2; ++ps) { const int r = ps * 64 + (tid >> 3), c4 = (tid & 7) * 4;
            v[b][ps] = nb < nbmax ? __builtin_nontemporal_load((const f32x4*)(W + (size_t)(k0 + r) * N + nb * 32 + c4)) : (f32x4){0.f, 0.f, 0.f, 0.f}; } }
    float sk[2];
#pragma unroll
    for (int ps = 0; ps < 2; ++ps) sk[ps] = kscale ? kscale[k0 + ps * 64 + (tid >> 3)] : 1.0f;
#pragma unroll
    for (int b = 0; b < NB; ++b)
#pragma unroll
        for (int ps = 0; ps < 2; ++ps) { const int r = ps * 64 + (tid >> 3), c4 = (tid & 7) * 4; LAS float* tp = t + b * (128 * 33) + r * 33 + c4;
            tp[0] = v[b][ps][0] * sk[ps]; tp[1] = v[b][ps][1] * sk[ps]; tp[2] = v[b][ps][2] * sk[ps]; tp[3] = v[b][ps][3] * sk[ps]; }
    __syncthreads();
#pragma unroll
    for (int b = 0; b < NB; ++b) { const int nb = nb0 + b;
        if (nb < nbmax) { const int n = tid >> 4, kc = (tid & 15) * 8; const LAS float* tb = t + b * (128 * 33);
            const int drow = WINMAP ? win_rowmap(nb * 32) : nb * 32;
            u32x4 o; o.x = pk2(tb[(kc + 0) * 33 + n], tb[(kc + 1) * 33 + n]); o.y = pk2(tb[(kc + 2) * 33 + n], tb[(kc + 3) * 33 + n]);
            o.z = pk2(tb[(kc + 4) * 33 + n], tb[(kc + 5) * 33 + n]); o.w = pk2(tb[(kc + 6) * 33 + n], tb[(kc + 7) * 33 + n]);
            *(u32x4*)(WT + (size_t)(drow + n) * K + k0 + kc) = o; } }
    __syncthreads();
}
DI void phase0a(const Params& p, LAS unsigned char* lds) {
    const int tid = otid();
    constexpr int N_ADA = 96, N_PE = 64, N_Z = 28;
    for (int it = blockIdx.x; it < N_ADA + N_PE + N_Z; it += gridDim.x) {
        if (it < N_ADA) p0_ada_item(p, lds, it);
        else if (it >= N_ADA + N_PE) { const int j = it - N_ADA - N_PE; u32x4* z = (u32x4*)((bf16_t*)(p.ws + OFF_WIN) + (size_t)5152 * 1024) + (size_t)j * 1024 + tid; z[0] = (u32x4){0u, 0u, 0u, 0u}; z[512] = (u32x4){0u, 0u, 0u, 0u}; }
        else { const int j = it - N_ADA; const int e = j * 512 + tid; const int pos = e >> 9, f = e & 255, isc = (e >> 8) & 1;
            const float om = ex2(-(float)f * (13.287712379549449f / 256.0f));
            float ang = (float)pos * om;
            const float kk = rintf(ang * 0.15915494309189535f); ang = fmaf(-kk, 6.2831854820251465f, ang); ang = fmaf(-kk, -1.7484556e-07f, ang);
            ((float*)(p.ws + OFF_PE))[e] = isc ? __cosf(ang) : __sinf(ang); }
    }
}
DI void phase0b(const Params& p, LAS unsigned char* lds, int first, int last, int b0, int stride) {
    const int tid = otid();
    constexpr int N_WIN = 8 * 41, N_WOUT = 16 * 8, N_FF1 = 8 * 32, N_FF2 = 32 * 8, N_WSB = 32;
    constexpr int E2 = N_WIN, E3 = E2 + N_WOUT, E4 = E3 + N_FF1, E5 = E4 + N_FF2, E6 = E5 + N_WSB;
    if (last > E6) last = E6;
    if (b0 < 0) return;
    for (int it = first + b0; it < last; it += stride) {
        if (it < E2) { const int j = it, nbb = j % 41, kb = j / 41; p0_tr_item<4, true>(p.in[8], 1024, 5152, (bf16_t*)(p.ws + OFF_WIN), kb, nbb * 4, 161, nullptr, lds); }
        else if (it < E3) { const int j = it - E2, nbb = j % 8, kb = j / 8; p0_tr_item<4, false>(p.in[19], 2048, 1024, (bf16_t*)(p.ws + OFF_WOUT), kb, nbb * 4, 32, kb < 8 ? p.in[14] : nullptr, lds); }
        else if (it < E4) { const int j = it - E3, nbb = j % 32, kb = j / 32; p0_tr_item<4, false>(p.in[21], 1024, 4096, (bf16_t*)(p.ws + OFF_WFF1), kb, nbb * 4, 128, nullptr, lds); }
        else if (it < E5) { const int j = it - E4, nbb = j % 8, kb = j / 8; p0_tr_item<4, false>(p.in[22], 4096, 1024, (bf16_t*)(p.ws + OFF_WFF2), kb, nbb * 4, 32, nullptr, lds); }
        else { const int j = it - E5; const int e = (j * 512 + tid) * 8; const f32x4 a = *(const f32x4*)(p.in[17] + e), b = *(const f32x4*)(p.in[17] + e + 4);
            u32x4 o; o.x = pk2(a[0], a[1]); o.y = pk2(a[2], a[3]); o.z = pk2(b[0], b[1]); o.w = pk2(b[2], b[3]); *(u32x4*)((bf16_t*)(p.ws + OFF_WSB) + e) = o; }
    }
}

template <int RB, int NQ> struct RowBufN { f32x4 v[RB][4]; u32x2 q[NQ > 0 ? NQ : 1][RB][4]; };
template <int WHICH, int NQ> DI void norm_mod_rows(const Params& p, int row_lo, int row_hi) {
    const int t_ = otid(); const int lane = t_ & 63, gw = blockIdx.x * 8 + (t_ >> 6), nw = gridDim.x * 8;
    const float* g = WHICH == 0 ? p.in[7] : p.in[20];
    const float* mod = (const float*)(p.ws + OFF_MOD);
    const float* pe = (const float*)(p.ws + OFF_PE);
    bf16_t* Hb = (bf16_t*)(p.ws + OFF_HB);
    const bf16_t* Pa = (const bf16_t*)(p.ws + OFF_P3A); const bf16_t* Pq = (const bf16_t*)(p.ws + OFF_P3B);
    constexpr int RB = WHICH == 0 ? 4 : (NQ == 4 ? 1 : 2);
    typedef RowBufN<RB, NQ> Buf;
    int ccur = -1; f32x4 pa[4], pb[4];
    auto load = [&](Buf& B, int row0) {
#pragma unroll
        for (int r = 0; r < RB; ++r) { const int row = row0 + r; const float* xr = xrow_ptr(p, row);
#pragma unroll
            for (int j = 0; j < 4; ++j) { B.v[r][j] = __builtin_nontemporal_load((const f32x4*)(xr + 4 * lane + 256 * j));
                if (NQ >= 1) B.q[0][r][j] = *(const u32x2*)(Pa + (size_t)row * DM + 4 * lane + 256 * j);
                if (NQ == 4) {
#pragma unroll
                    for (int k = 1; k < 4; ++k) B.q[k][r][j] = *(const u32x2*)(Pq + ((size_t)(k - 1) * 4096 + (row - 16384)) * DM + 4 * lane + 256 * j); } } }
    };
    auto process = [&](Buf& B, int row0) {
        float s[RB];
        const int cnd = cond_of(row0);
        if (cnd != ccur) { ccur = cnd; const float* mc = mod + (size_t)cnd * 6144 + (WHICH == 0 ? 0 : 3072);
#pragma unroll
            for (int j = 0; j < 4; ++j) { const int c = 4 * lane + 256 * j; pa[j] = *(const f32x4*)(g + c) * (*(const f32x4*)(mc + 1024 + c) + 1.0f); pb[j] = *(const f32x4*)(mc + c); } }
#pragma unroll
        for (int r = 0; r < RB; ++r) { const int row = row0 + r; s[r] = 0.f;
#pragma unroll
            for (int j = 0; j < 4; ++j) {
                if (row >= NPR) { const int pos = (row - NPR) & 4095; const int pr = j < 2 ? (pos >> 6) : (pos & 63); B.v[r][j] += *(const f32x4*)(pe + pr * 512 + ((4 * lane + 256 * j) & 511)); }
                if (NQ >= 1) {
#pragma unroll
                    for (int k = 0; k < (NQ > 0 ? NQ : 1); ++k) B.v[r][j] += (f32x4){bflo(B.q[k][r][j].x), bfhi(B.q[k][r][j].x), bflo(B.q[k][r][j].y), bfhi(B.q[k][r][j].y)};
                    { u32x2 xo; xo.x = pk2(B.v[r][j][0], B.v[r][j][1]); xo.y = pk2(B.v[r][j][2], B.v[r][j][3]); *(u32x2*)((bf16_t*)(p.out + (size_t)row * DM) + 4 * lane + 256 * j) = xo; } }
                s[r] += (B.v[r][j][0] * B.v[r][j][0] + B.v[r][j][1] * B.v[r][j][1]) + (B.v[r][j][2] * B.v[r][j][2] + B.v[r][j][3] * B.v[r][j][3]); } }
#pragma unroll
        for (int o = 1; o < 64; o <<= 1) {
#pragma unroll
            for (int r = 0; r < RB; ++r) s[r] += __shfl_xor(s[r], o); }
#pragma unroll
        for (int r = 0; r < RB; ++r) { const int row = row0 + r;
            const float rstd = __builtin_amdgcn_rsqf(s[r] * (1.0f / 1024.0f) + EPSF);
#pragma unroll
            for (int j = 0; j < 4; ++j) { const int c = 4 * lane + 256 * j;
                const f32x4 h = B.v[r][j] * rstd * pa[j] + pb[j];
                u32x2 o; o.x = pk2(h[0], h[1]); o.y = pk2(h[2], h[3]); *(u32x2*)(Hb + (size_t)row * DM + c) = o; } }
    };
    Buf A, B2; const int step = nw * RB;
    int r0 = row_lo + gw * RB;
    if (r0 < row_hi) load(A, r0);
    while (r0 < row_hi) {
        const int r1 = r0 + step;
        if (r1 < row_hi) load(B2, r1);
        process(A, r0);
        if (r1 >= row_hi) break;
        const int r2 = r1 + step;
        if (r2 < row_hi) load(A, r2);
        process(B2, r1);
        r0 = r2;
    }
}
template <int WHICH> DI void phase_norm_mod(const Params& p) {
    if (WHICH == 0) norm_mod_rows<0, 0>(p, 0, MT);
    else { norm_mod_rows<1, 1>(p, 0, 16384); norm_mod_rows<1, 4>(p, 16384, MT); }
}
template <bool LATE> struct RowBufF { f32x4 v[2][4]; u32x2 xr[2][4]; u32x2 qa[2][4]; u32x2 q1[LATE ? 2 : 1][4], q2[LATE ? 2 : 1][4], q3[LATE ? 2 : 1][4]; };
template <bool LATE> DI void final_norm_rows(const Params& p, int row_lo, int row_hi) {
    const int t_ = otid(); const int lane = t_ & 63, gw = blockIdx.x * 8 + (t_ >> 6), nw = gridDim.x * 8;
    const float* g = p.in[23];
    const bf16_t* Pa = (const bf16_t*)(p.ws + OFF_P5A); const bf16_t* Pq = (const bf16_t*)(p.ws + OFF_P5B);
    constexpr int RB = 2;
    typedef RowBufF<LATE> Buf;
    f32x4 gg[4];
#pragma unroll
    for (int j = 0; j < 4; ++j) gg[j] = *(const f32x4*)(g + 4 * lane + 256 * j);
    auto load = [&](Buf& B, int row0) {
#pragma unroll
        for (int r = 0; r < RB; ++r) { const size_t ro = (size_t)(row0 + r) * DM + 4 * lane; const size_t rq = (size_t)(row0 + r - 16384) * DM + 4 * lane;
#pragma unroll
            for (int j = 0; j < 4; ++j) { B.xr[r][j] = *(const u32x2*)((const bf16_t*)(p.out + (size_t)(row0 + r) * DM) + 4 * lane + 256 * j); B.qa[r][j] = *(const u32x2*)(Pa + ro + 256 * j);
                if (LATE) { B.q1[r][j] = *(const u32x2*)(Pq + rq + 256 * j); B.q2[r][j] = *(const u32x2*)(Pq + (size_t)4096 * DM + rq + 256 * j); B.q3[r][j] = *(const u32x2*)(Pq + (size_t)8192 * DM + rq + 256 * j); } } }
    };
    auto process = [&](Buf& B, int row0) {
        float s[RB];
#pragma unroll
        for (int r = 0; r < RB; ++r) { s[r] = 0.f;
#pragma unroll
            for (int j = 0; j < 4; ++j) { B.v[r][j] = (f32x4){bflo(B.xr[r][j].x) + bflo(B.qa[r][j].x), bfhi(B.xr[r][j].x) + bfhi(B.qa[r][j].x), bflo(B.xr[r][j].y) + bflo(B.qa[r][j].y), bfhi(B.xr[r][j].y) + bfhi(B.qa[r][j].y)};
                if (LATE) { B.v[r][j] += (f32x4){bflo(B.q1[r][j].x) + bflo(B.q2[r][j].x) + bflo(B.q3[r][j].x), bfhi(B.q1[r][j].x) + bfhi(B.q2[r][j].x) + bfhi(B.q3[r][j].x),
                                                  bflo(B.q1[r][j].y) + bflo(B.q2[r][j].y) + bflo(B.q3[r][j].y), bfhi(B.q1[r][j].y) + bfhi(B.q2[r][j].y) + bfhi(B.q3[r][j].y)}; }
                s[r] += (B.v[r][j][0] * B.v[r][j][0] + B.v[r][j][1] * B.v[r][j][1]) + (B.v[r][j][2] * B.v[r][j][2] + B.v[r][j][3] * B.v[r][j][3]); } }
#pragma unroll
        for (int o = 1; o < 64; o <<= 1) {
#pragma unroll
            for (int r = 0; r < RB; ++r) s[r] += __shfl_xor(s[r], o); }
#pragma unroll
        for (int r = 0; r < RB; ++r) { float* xr = p.out + (size_t)(row0 + r) * DM;
            const float rstd = __builtin_amdgcn_rsqf(s[r] * (1.0f / 1024.0f) + EPSF);
#pragma unroll
            for (int j = 0; j < 4; ++j) { const int c = 4 * lane + 256 * j; __builtin_nontemporal_store(B.v[r][j] * rstd * gg[j], (f32x4*)(xr + c)); } }
    };
    Buf A, B2; const int step = nw * RB;
    int r0 = row_lo + gw * RB;
    if (r0 < row_hi) load(A, r0);
    while (r0 < row_hi) {
        const int r1 = r0 + step;
        if (r1 < row_hi) load(B2, r1);
        process(A, r0);
        if (r1 >= row_hi) break;
        const int r2 = r1 + step;
        if (r2 < row_hi) load(A, r2);
        process(B2, r1);
        r0 = r2;
    }
}
DI void phase_final_norm(const Params& p) {
    final_norm_rows<false>(p, 0, 16384);
    final_norm_rows<true>(p, 16384, MT);
}

template <bool WITH_C> DI void stage_conv(const Params& p, int cidx, int g, LAS unsigned char* Ximg, LAS unsigned char* Bimg, int bstride, LAS unsigned char* Cimg) {
    int tid_ = threadIdx.x; asm volatile("" : "+v"(tid_));
    const int tid = tid_, co = tid & 63, rg = tid >> 6;
    if (WITH_C || co < 48) {
        const bf16_t* XBC = (const bf16_t*)p.out;
        const int ch = co < 32 ? g * 256 + co * 8 : (co < 48 ? 1024 + g * 128 + (co - 32) * 8 : 1536 + g * 128 + (co - 48) * 8);
        LAS unsigned char* dst = co < 32 ? Ximg + co * 16 : (co < 48 ? Bimg + (co - 32) * 16 : Cimg + (co - 48) * 16);
        const int dstride = co < 32 ? 544 : (co < 48 ? bstride : 272);
        const int tok0 = cidx * 128;
        const int seq_lo = tok0 < NPR ? (tok0 & ~255) : (NPR + ((tok0 - NPR) & ~4095));
        const int seq_hi = seq_lo + (tok0 < NPR ? 256 : 4096);
        f32x2 wv[5][4], bv[4];
#pragma unroll
        for (int k = 0; k < 5; ++k) { const f32x4 a = *(const f32x4*)(p.in[9] + k * 2048 + ch), b = *(const f32x4*)(p.in[9] + k * 2048 + ch + 4);
            wv[k][0] = (f32x2){a[0], a[1]}; wv[k][1] = (f32x2){a[2], a[3]}; wv[k][2] = (f32x2){b[0], b[1]}; wv[k][3] = (f32x2){b[2], b[3]}; }
        { const f32x4 a = *(const f32x4*)(p.in[10] + ch), b = *(const f32x4*)(p.in[10] + ch + 4);
          bv[0] = (f32x2){a[0], a[1]}; bv[1] = (f32x2){a[2], a[3]}; bv[2] = (f32x2){b[0], b[1]}; bv[3] = (f32x2){b[2], b[3]}; }
#pragma unroll 1
        for (int hf = 0; hf < 2; ++hf) {
            const int rl = rg * 16 + 8 * hf, tb = tok0 + rl;
            u32x4 raw[12];
#pragma unroll
            for (int r = 0; r < 12; ++r) { const int t = tb - 2 + r; raw[r] = (t >= seq_lo && t < seq_hi) ? *(const u32x4*)(XBC + (size_t)t * 2048 + ch) : (u32x4){0u, 0u, 0u, 0u}; }
            f32x2 xw[12][4];
#pragma unroll
            for (int r = 0; r < 12; ++r) { xw[r][0] = (f32x2){bflo(raw[r].x), bfhi(raw[r].x)}; xw[r][1] = (f32x2){bflo(raw[r].y), bfhi(raw[r].y)};
                xw[r][2] = (f32x2){bflo(raw[r].z), bfhi(raw[r].z)}; xw[r][3] = (f32x2){bflo(raw[r].w), bfhi(raw[r].w)}; }
#pragma unroll
            for (int i = 0; i < 8; ++i) {
                f32x2 o[4];
#pragma unroll
                for (int c = 0; c < 4; ++c) { o[c] = bv[c];
#pragma unroll
                    for (int k = 0; k < 5; ++k) o[c] = __builtin_elementwise_fma(wv[k][c], xw[i + k][c], o[c]);
                    const f32x2 t = o[c] * (-LOG2E); f32x2 d; d.x = ex2(t.x); d.y = ex2(t.y); d = d + 1.0f;
                    f32x2 r; r.x = __builtin_amdgcn_rcpf(d.x); r.y = __builtin_amdgcn_rcpf(d.y); o[c] = o[c] * r; }
                u32x4 ov; ov.x = pk2(o[0].x, o[0].y); ov.y = pk2(o[1].x, o[1].y); ov.z = pk2(o[2].x, o[2].y); ov.w = pk2(o[3].x, o[3].y);
                *(LAS u32x4*)(dst + (rl + i) * dstride) = ov;
            }
        }
    }
}

DI void p23_item(const Params& p, LAS unsigned char* lds, int cidx, int g) {
    int tid_ = threadIdx.x; asm volatile("" : "+v"(tid_));
    const int tid = tid_, wid = __builtin_amdgcn_readfirstlane(tid >> 6), lane = tid & 63, i16 = lane & 15, G = lane >> 4;
    bf16_t* S = (bf16_t*)(p.ws + OFF_S);
    const int tok0 = cidx * 128;
    LAS unsigned char* Ximg = lds;
    LAS unsigned char* Bimg = lds + 69632;
    LAS float* WT = (LAS float*)(lds + 106496);
    LAS float* DTs = (LAS float*)(lds + 129024);
    LAS float* A2s = (LAS float*)(lds + 133120);
    if (wid == 0) {
        const int seg = lane & 7, dhl = lane >> 3, d = dhl >> 2, dh = d * 16 + 4 * g + (dhl & 3);
        const float* DT = (const float*)(p.ws + OFF_DT);
        f32x2* DTA = (f32x2*)(p.ws + OFF_DTA);
        const float dtb = p.in[11][dh], A2 = -__expf(p.in[12][dh]) * LOG2E;
        float dt[16]; float tot = 0.f;
#pragma unroll
        for (int jj = 0; jj < 16; ++jj) { const int o = seg * 16 + jj; const int j = d ? 127 - o : o;
            const float x = DT[(size_t)(tok0 + j) * 32 + dh] + dtb;
            dt[jj] = fmaxf(x, 0.f) + log1pf(__expf(-fabsf(x))); tot += dt[jj] * A2; }
        float inc = tot;
#pragma unroll
        for (int o = 1; o < 8; o <<= 1) { const float t = __shfl_up(inc, o, 8); if (seg >= o) inc += t; }
        float run = inc - tot;
#pragma unroll
        for (int jj = 0; jj < 16; ++jj) { const int o = seg * 16 + jj; const int j = d ? 127 - o : o;
            run += dt[jj] * A2; DTA[(size_t)(tok0 + j) * 32 + dh] = (f32x2){dt[jj], run}; DTs[dhl * 128 + j] = dt[jj]; A2s[dhl * 128 + j] = run; }
    }
    stage_conv<false>(p, cidx, g, Ximg, Bimg, 288, nullptr);
    __syncthreads();
#pragma unroll
    for (int r = 0; r < 2; ++r) { const int j = tid & 127, dhl = (tid >> 7) + 4 * r, d = dhl >> 2;
        WT[dhl * 128 + j] = DTs[dhl * 128 + j] * ex2(A2s[dhl * 128 + (d ? 0 : 127)] - A2s[dhl * 128 + j]); }
    __syncthreads();
    const int hl = wid >> 1, d = wid & 1, dhl = d * 4 + hl;
    bf16_t* So = S + ((size_t)(cidx * 2 + d) * 16 + 4 * g + hl) * 8192;
#pragma unroll 1
    for (int nh = 0; nh < 2; ++nh) {
        f32x4 acc[4][4];
#pragma unroll
        for (int a = 0; a < 4; ++a)
#pragma unroll
            for (int b = 0; b < 4; ++b) acc[a][b] = (f32x4){0.f, 0.f, 0.f, 0.f};
#pragma unroll 1
        for (int ks = 0; ks < 4; ++ks) {
            const int r0 = 32 * ks + 4 * G + (i16 >> 2), cb = 4 * (i16 & 3);
            bf16x8 bfr[4];
#pragma unroll
            for (int nt = 0; nt < 4; ++nt) bfr[nt] = cat8(trrd(Bimg + r0 * 288 + (64 * nh + 16 * nt + cb) * 2), trrd(Bimg + (r0 + 16) * 288 + (64 * nh + 16 * nt + cb) * 2));
            const f32x4 w0 = *(const LAS f32x4*)(WT + dhl * 128 + 32 * ks + 4 * G), w1 = *(const LAS f32x4*)(WT + dhl * 128 + 32 * ks + 16 + 4 * G);
#pragma unroll
            for (int pt = 0; pt < 4; ++pt) {
                const s16x4 xa = trrd(Ximg + r0 * 544 + (hl * 64 + 16 * pt + cb) * 2), xb = trrd(Ximg + (r0 + 16) * 544 + (hl * 64 + 16 * pt + cb) * 2);
                u32x4 xs;
                xs.x = pk2(__uint_as_float((unsigned)(unsigned short)xa[0] << 16) * w0[0], __uint_as_float((unsigned)(unsigned short)xa[1] << 16) * w0[1]);
                xs.y = pk2(__uint_as_float((unsigned)(unsigned short)xa[2] << 16) * w0[2], __uint_as_float((unsigned)(unsigned short)xa[3] << 16) * w0[3]);
                xs.z = pk2(__uint_as_float((unsigned)(unsigned short)xb[0] << 16) * w1[0], __uint_as_float((unsigned)(unsigned short)xb[1] << 16) * w1[1]);
                xs.w = pk2(__uint_as_float((unsigned)(unsigned short)xb[2] << 16) * w1[2], __uint_as_float((unsigned)(unsigned short)xb[3] << 16) * w1[3]);
                const bf16x8 xf = u4_as_bf8(xs);
#pragma unroll
                for (int nt = 0; nt < 4; ++nt) acc[nt][pt] = __builtin_amdgcn_mfma_f32_16x16x32_bf16(bfr[nt], xf, acc[nt][pt], 0, 0, 0);
            }
        }
        LAS unsigned char* T = lds + 110592 + wid * 2304;
#pragma unroll
        for (int pt = 0; pt < 4; ++pt) {
#pragma unroll
            for (int nt = 0; nt < 4; ++nt) { u32x2 o; o.x = pk2(acc[nt][pt][0], acc[nt][pt][1]); o.y = pk2(acc[nt][pt][2], acc[nt][pt][3]);
                *(LAS u32x2*)(T + i16 * 144 + (16 * nt + 4 * G) * 2) = o; }
#pragma unroll
            for (int j = 0; j < 2; ++j) { const int q = lane + 64 * j, row = q >> 3, c = q & 7;
                *(u32x4*)(So + (16 * pt + row) * 128 + 64 * nh + 8 * c) = *(const LAS u32x4*)(T + row * 144 + c * 16); }
        }
    }
    __syncthreads();
}
DI void p3_cmlp_item(const Params& p, LAS unsigned char* lds, int cidx, int hh) {
    int tid_ = threadIdx.x; asm volatile("" : "+v"(tid_));
    const int tid = tid_, wid = __builtin_amdgcn_readfirstlane(tid >> 6), lane = tid & 63, i16 = lane & 15, G = lane >> 4;
    const bf16_t* VN = (const bf16_t*)(p.ws + OFF_V);
    const bf16_t* Wsb = (const bf16_t*)(p.ws + OFF_WSB) + (size_t)hh * 16384;
    bf16_t* U = (bf16_t*)(p.ws + OFF_U);
    const int tok0 = cidx * 128;
    LAS unsigned char* Vimg = lds;
    LAS unsigned char* Wimg = lds + 36864;
    {
        const float* LNP = (const float*)(p.ws + OFF_LNP);
        LAS f32x2* STs = (LAS f32x2*)(lds + 71680);
        const int cc = tid & 15;
        u32x4 vv[4], ww[4];
#pragma unroll
        for (int itr = 0; itr < 4; ++itr) { const int row = itr * 32 + (tid >> 4);
            vv[itr] = *(const u32x4*)(VN + (size_t)(tok0 + row) * DM + hh * 128 + cc * 8);
            ww[itr] = *(const u32x4*)(Wsb + row * 128 + cc * 8); }
        if (tid < 128) { float s1 = 0.f, s2 = 0.f;
#pragma unroll
            for (int k = 0; k < 8; ++k) { const f32x4 t = *(const f32x4*)(LNP + (size_t)(tok0 + tid) * 32 + 4 * k); s1 += t[0] + t[2]; s2 += t[1] + t[3]; }
            const float mu = s1 * (1.0f / 1024.0f);
            STs[tid] = (f32x2){mu, __builtin_amdgcn_rsqf(fmaxf(s2 * (1.0f / 1024.0f) - mu * mu, 0.f) + EPSF)}; }
        const f32x4 g0 = *(const f32x4*)(p.in[15] + hh * 128 + cc * 8), g1 = *(const f32x4*)(p.in[15] + hh * 128 + cc * 8 + 4);
        const f32x4 b0 = *(const f32x4*)(p.in[16] + hh * 128 + cc * 8), b1 = *(const f32x4*)(p.in[16] + hh * 128 + cc * 8 + 4);
        __syncthreads();
#pragma unroll
        for (int itr = 0; itr < 4; ++itr) { const int row = itr * 32 + (tid >> 4);
            const f32x2 st = STs[row]; const float mu = st[0], rstd = st[1];
            const u32x4 a = vv[itr]; u32x4 o;
            o.x = pk2((bflo(a.x) - mu) * rstd * g0[0] + b0[0], (bfhi(a.x) - mu) * rstd * g0[1] + b0[1]); o.y = pk2((bflo(a.y) - mu) * rstd * g0[2] + b0[2], (bfhi(a.y) - mu) * rstd * g0[3] + b0[3]);
            o.z = pk2((bflo(a.z) - mu) * rstd * g1[0] + b1[0], (bfhi(a.z) - mu) * rstd * g1[1] + b1[1]); o.w = pk2((bflo(a.w) - mu) * rstd * g1[2] + b1[2], (bfhi(a.w) - mu) * rstd * g1[3] + b1[3]);
            *(LAS u32x4*)(Vimg + row * 288 + cc * 16) = o;
            *(LAS u32x4*)(Wimg + row * 272 + cc * 16) = ww[itr]; }
    }
    __syncthreads();
    bf16x8 wf[4];
#pragma unroll
    for (int ks = 0; ks < 4; ++ks) { const u32x2 a = *(const LAS u32x2*)(Wimg + (16 * wid + i16) * 272 + (32 * ks + 4 * G) * 2), b = *(const LAS u32x2*)(Wimg + (16 * wid + i16) * 272 + (32 * ks + 16 + 4 * G) * 2);
        wf[ks] = u4_as_bf8((u32x4){a.x, a.y, b.x, b.y}); }
    const int tok = tok0 + 16 * wid + i16;
    const float bs = p.in[18][hh * 128 + 16 * wid + i16];
#pragma unroll
    for (int mt = 0; mt < 8; ++mt) {
        f32x4 acc = (f32x4){0.f, 0.f, 0.f, 0.f};
#pragma unroll
        for (int ks = 0; ks < 4; ++ks) { const int r0 = 32 * ks + 4 * G + (i16 >> 2), cb = 16 * mt + 4 * (i16 & 3);
            const bf16x8 vf = cat8(trrd(Vimg + r0 * 288 + cb * 2), trrd(Vimg + (r0 + 16) * 288 + cb * 2));
            acc = __builtin_amdgcn_mfma_f32_16x16x32_bf16(vf, wf[ks], acc, 0, 0, 0); }
        bf16_t* up = U + (size_t)tok * DM + hh * 128 + 16 * mt + 4 * G;
        const u32x2 uu = *(const u32x2*)up;
        u32x2 o; o.x = pk2(bflo(uu.x) * (acc[0] + bs), bfhi(uu.x) * (acc[1] + bs)); o.y = pk2(bflo(uu.y) * (acc[2] + bs), bfhi(uu.y) * (acc[3] + bs));
        *(u32x2*)up = o;
    }
    __syncthreads();
}
DI void phase3(const Params& p, LAS unsigned char* lds) {
    const int b = blockIdx.x;
    if (gridDim.x == 256) {
        for (int it = b; it < 640; it += 256) p23_item(p, lds, it >> 2, it & 3);
        if (b >= 128) for (int k = 0; k < 5; ++k) { const int it = (b - 128) * 5 + k; p3_cmlp_item(p, lds, it >> 3, it & 7); }
    } else {
        for (int it = b; it < 1920; it += gridDim.x) {
            if (it < 640) p23_item(p, lds, it >> 2, it & 3);
            else p3_cmlp_item(p, lds, (it - 640) >> 3, (it - 640) & 7);
        }
    }
}

DI void phase4(const Params& p) {
    bf16_t* S = (bf16_t*)(p.ws + OFF_S);
    const f32x2* DTA = (const f32x2*)(p.ws + OFF_DTA);
    float* nst = p.out + (size_t)MT * DM;
    const int gt = blockIdx.x * 512 + otid(), ngt = gridDim.x * 512;
    for (int idx = gt; idx < 131072 + 524288; idx += ngt) {
        const bool samp = idx < 131072;
        const int id2 = samp ? idx : idx - 131072;
        const int sq = id2 >> 15, rem = id2 & 32767, d = rem >> 14, h = (rem >> 10) & 15, pn = rem & 1023;
        const int c0 = samp ? 32 + sq * 32 : sq * 2, nc = samp ? 32 : 2;
        float hc[8];
        if (samp) { const float* h0 = p.in[2] + ((size_t)(sq * 2 + d) * 16 + h) * 8192 + pn * 8; const f32x4 a = __builtin_nontemporal_load((const f32x4*)h0), b = __builtin_nontemporal_load((const f32x4*)(h0 + 4));
            hc[0] = a[0]; hc[1] = a[1]; hc[2] = a[2]; hc[3] = a[3]; hc[4] = b[0]; hc[5] = b[1]; hc[6] = b[2]; hc[7] = b[3]; }
        else {
#pragma unroll
            for (int e = 0; e < 8; ++e) hc[e] = 0.f; }
        if (samp) {
#pragma unroll 1
            for (int kb = 0; kb < 32; kb += 8) {
                u32x4 tv[8]; float dec[8]; bf16_t* sp[8];
#pragma unroll
                for (int k2 = 0; k2 < 8; ++k2) { const int k = kb + k2; const int c = d ? 31 - k : k; const int cidx = c0 + c;
                    sp[k2] = S + ((size_t)(cidx * 2 + d) * 16 + h) * 8192 + pn * 8; tv[k2] = *(const u32x4*)sp[k2];
                    dec[k2] = ex2(DTA[(size_t)(cidx * 128 + (d ? 0 : 127)) * 32 + d * 16 + h][1]); }
#pragma unroll
                for (int k2 = 0; k2 < 8; ++k2) {
                    u32x4 o; o.x = pk2(hc[0], hc[1]); o.y = pk2(hc[2], hc[3]); o.z = pk2(hc[4], hc[5]); o.w = pk2(hc[6], hc[7]);
                    *(u32x4*)sp[k2] = o;
                    const u32x4 t = tv[k2]; const float dc = dec[k2];
                    hc[0] = hc[0] * dc + bflo(t.x); hc[1] = hc[1] * dc + bfhi(t.x); hc[2] = hc[2] * dc + bflo(t.y); hc[3] = hc[3] * dc + bfhi(t.y);
                    hc[4] = hc[4] * dc + bflo(t.z); hc[5] = hc[5] * dc + bfhi(t.z); hc[6] = hc[6] * dc + bflo(t.w); hc[7] = hc[7] * dc + bfhi(t.w);
                }
            }
        } else {
            u32x4 tv[2]; float dec[2]; bf16_t* sp[2];
#pragma unroll
            for (int k2 = 0; k2 < 2; ++k2) { const int c = d ? 1 - k2 : k2; const int cidx = c0 + c;
                sp[k2] = S + ((size_t)(cidx * 2 + d) * 16 + h) * 8192 + pn * 8; tv[k2] = *(const u32x4*)sp[k2];
                dec[k2] = ex2(DTA[(size_t)(cidx * 128 + (d ? 0 : 127)) * 32 + d * 16 + h][1]); }
#pragma unroll
            for (int k2 = 0; k2 < 2; ++k2) {
                u32x4 o; o.x = pk2(hc[0], hc[1]); o.y = pk2(hc[2], hc[3]); o.z = pk2(hc[4], hc[5]); o.w = pk2(hc[6], hc[7]);
                *(u32x4*)sp[k2] = o;
                const u32x4 t = tv[k2]; const float dc = dec[k2];
                hc[0] = hc[0] * dc + bflo(t.x); hc[1] = hc[1] * dc + bfhi(t.x); hc[2] = hc[2] * dc + bflo(t.y); hc[3] = hc[3] * dc + bfhi(t.y);
                hc[4] = hc[4] * dc + bflo(t.z); hc[5] = hc[5] * dc + bfhi(t.z); hc[6] = hc[6] * dc + bflo(t.w); hc[7] = hc[7] * dc + bfhi(t.w);
            }
        }
        if (!samp) { float* o = nst + ((size_t)(sq * 2 + d) * 16 + h) * 8192 + pn * 8;
            __builtin_nontemporal_store((f32x4){hc[0], hc[1], hc[2], hc[3]}, (f32x4*)o); __builtin_nontemporal_store((f32x4){hc[4], hc[5], hc[6], hc[7]}, (f32x4*)(o + 4)); }
    }
}

DI void p5_item(const Params& p, LAS unsigned char* lds, int cidx, int g) {
    int tid_ = threadIdx.x; asm volatile("" : "+v"(tid_));
    const int tid = tid_, wid = __builtin_amdgcn_readfirstlane(tid >> 6), lane = tid & 63, i16 = lane & 15, G = lane >> 4;
    const f32x2* DTA = (const f32x2*)(p.ws + OFF_DTA);
    const bf16_t* HS = (const bf16_t*)(p.ws + OFF_S);
    bf16_t* ZG = (bf16_t*)(p.ws + OFF_ZG);
    float* SSQ = (float*)(p.ws + OFF_SSQ);
    const int tok0 = cidx * 128;
    LAS unsigned char* Cimg = lds;
    LAS unsigned char* Ximg = lds + 34816;
    LAS unsigned char* BHimg = lds + 104448;
    LAS float* A2s = (LAS float*)(lds + 139264);
    LAS float* LJs = (LAS float*)(lds + 143360);
    stage_conv<true>(p, cidx, g, Ximg, BHimg, 272, Cimg);
#pragma unroll
    for (int r = 0; r < 2; ++r) { const int j = tid & 127, dhl = (tid >> 7) + 4 * r, d = dhl >> 2, hl = dhl & 3;
        const f32x2 me = DTA[(size_t)(tok0 + j) * 32 + d * 16 + 4 * g + hl];
        A2s[dhl * 128 + j] = me[1]; LJs[dhl * 128 + j] = __builtin_amdgcn_logf(me[0]) - me[1]; }
    __syncthreads();
    u32x4 hreg[4];
    {
#pragma unroll
        for (int itr = 0; itr < 4; ++itr) { const int q = itr * 512 + tid; const int row = q >> 4, cc = q & 15;
            hreg[itr] = *(const u32x4*)(HS + ((size_t)(cidx * 2 + 0) * 16 + 4 * g + 0 + (row >> 6)) * 8192 + (row & 63) * 128 + cc * 8); }
    }
    bf16x8 cf[4];
#pragma unroll
    for (int ks = 0; ks < 4; ++ks) cf[ks] = *(const LAS bf16x8*)(Cimg + (16 * wid + i16) * 272 + (32 * ks + 8 * G) * 2);
    f32x4 cbt[8];
#pragma unroll
    for (int jt = 0; jt < 8; ++jt) { cbt[jt] = (f32x4){0.f, 0.f, 0.f, 0.f};
#pragma unroll
        for (int ks = 0; ks < 4; ++ks) { const bf16x8 bf = *(const LAS bf16x8*)(BHimg + (16 * jt + i16) * 272 + (32 * ks + 8 * G) * 2);
            cbt[jt] = __builtin_amdgcn_mfma_f32_16x16x32_bf16(bf, cf[ks], cbt[jt], 0, 0, 0); }
        asm volatile("" : "+v"(cbt[jt])); if (jt & 1) __builtin_amdgcn_sched_barrier(0); }
    f32x4 Y[4][4];
#pragma unroll
    for (int a = 0; a < 4; ++a)
#pragma unroll
        for (int b = 0; b < 4; ++b) Y[a][b] = (f32x4){0.f, 0.f, 0.f, 0.f};
    __syncthreads();
#pragma unroll 1
    for (int d = 0; d < 2; ++d) {
#pragma unroll
        for (int hp = 0; hp < 2; ++hp) {
#pragma unroll
            for (int itr = 0; itr < 4; ++itr) { const int q = itr * 512 + tid; const int row = q >> 4, cc = q & 15;
                *(LAS u32x4*)(BHimg + row * 272 + cc * 16) = hreg[itr]; }
            if (!(d == 1 && hp == 1)) { const int dn = hp == 1 ? d + 1 : d, hpn = hp == 1 ? 0 : 1;
#pragma unroll
                for (int itr = 0; itr < 4; ++itr) { const int q = itr * 512 + tid; const int row = q >> 4, cc = q & 15;
                    hreg[itr] = *(const u32x4*)(HS + ((size_t)(cidx * 2 + dn) * 16 + 4 * g + 2 * hpn + (row >> 6)) * 8192 + (row & 63) * 128 + cc * 8); } }
            __syncthreads();
#pragma unroll
            for (int hh = 0; hh < 2; ++hh) {
                const int hl = 2 * hp + hh;
                const float ei = ex2(A2s[(d * 4 + hl) * 128 + 16 * wid + i16]);
#pragma unroll
                for (int mt = 0; mt < 4; ++mt) { f32x4 t = (f32x4){0.f, 0.f, 0.f, 0.f};
#pragma unroll
                    for (int ks = 0; ks < 4; ++ks) { const bf16x8 hf = *(const LAS bf16x8*)(BHimg + (hh * 64 + 16 * mt + i16) * 272 + (32 * ks + 8 * G) * 2);
                        t = __builtin_amdgcn_mfma_f32_16x16x32_bf16(hf, cf[ks], t, 0, 0, 0); }
                    Y[hl][mt] += t * ei; if (mt & 1) __builtin_amdgcn_sched_barrier(0); }
            }
            __syncthreads();
        }
    }
    const int tl4 = lane >> 2, c44 = lane & 3;
    bf16_t* zrow4 = ZG + (size_t)(tok0 + 16 * wid + tl4) * DM + g * 256;
    u32x4 zzA[4];
#pragma unroll
    for (int it2 = 0; it2 < 4; ++it2) zzA[it2] = *(const u32x4*)(zrow4 + (c44 + 4 * it2) * 8);
    float penf[4], penb[4];
#pragma unroll
    for (int e = 0; e < 4; ++e) { penf[e] = (4 * G + e <= i16) ? 0.f : -INFINITY; penb[e] = (4 * G + e >= i16) ? 0.f : -INFINITY; }
#pragma unroll 1
    for (int d = 0; d < 2; ++d) {
        float pen[4];
#pragma unroll
        for (int e = 0; e < 4; ++e) pen[e] = d ? penb[e] : penf[e];
#pragma unroll
        for (int hl = 0; hl < 4; ++hl) {
            const float ai = A2s[(d * 4 + hl) * 128 + 16 * wid + i16];
#pragma unroll
            for (int ks = 0; ks < 4; ++ks) {
                const bool need = d == 0 ? (2 * ks <= wid) : (2 * ks + 1 >= wid);
                if (need) {
                    float m[8];
#pragma unroll
                    for (int hf = 0; hf < 2; ++hf) { const int jt = 2 * ks + hf;
                        const bool diag = (jt == wid);
                        const bool incl = d == 0 ? (jt < wid) : (jt > wid);
                        const float tp = incl ? 0.f : -INFINITY;
                        const f32x4 lj = *(const LAS f32x4*)(LJs + (d * 4 + hl) * 128 + 16 * jt + 4 * G);
#pragma unroll
                        for (int e = 0; e < 4; ++e) { const float addp = diag ? pen[e] : tp;
                            m[4 * hf + e] = cbt[jt][e] * ex2(ai + lj[e] + addp); } }
                    u32x4 mm; mm.x = pk2(m[0], m[1]); mm.y = pk2(m[2], m[3]); mm.z = pk2(m[4], m[5]); mm.w = pk2(m[6], m[7]);
                    const bf16x8 mf = u4_as_bf8(mm);
                    const int r0 = 32 * ks + 4 * G + (i16 >> 2);
#pragma unroll
                    for (int mt = 0; mt < 4; ++mt) { const int cb = hl * 64 + 16 * mt + 4 * (i16 & 3);
                        const bf16x8 xf = cat8(trrd(Ximg + r0 * 544 + cb * 2), trrd(Ximg + (r0 + 16) * 544 + cb * 2));
                        Y[hl][mt] = __builtin_amdgcn_mfma_f32_16x16x32_bf16(xf, mf, Y[hl][mt], 0, 0, 0); }
                }
                __builtin_amdgcn_sched_barrier(0);
            }
        }
    }
    {
        LAS unsigned char* T = (wid < 4 ? Cimg : BHimg) + (wid & 3) * 8448;
        const int tl = lane >> 2, c4 = lane & 3;
        const int tok = tok0 + 16 * wid + tl;
        bf16_t* zrow = ZG + (size_t)tok * DM + g * 256;
        u32x4 zzB[4];
#pragma unroll
        for (int it2 = 0; it2 < 4; ++it2) zzB[it2] = *(const u32x4*)(zrow + (c4 + 4 * (4 + it2)) * 8);
#pragma unroll
        for (int hl = 0; hl < 4; ++hl) {
            const float dsk = p.in[13][4 * g + hl];
#pragma unroll
            for (int mt = 0; mt < 4; ++mt) { const int chl = hl * 64 + 16 * mt + 4 * G;
                const u32x2 xx = *(const LAS u32x2*)(Ximg + (16 * wid + i16) * 544 + chl * 2);
                u32x2 o; o.x = pk2(Y[hl][mt][0] + bflo(xx.x) * dsk, Y[hl][mt][1] + bfhi(xx.x) * dsk); o.y = pk2(Y[hl][mt][2] + bflo(xx.y) * dsk, Y[hl][mt][3] + bfhi(xx.y) * dsk);
                *(LAS u32x2*)(T + i16 * 528 + chl * 2) = o; }
        }
        float ssq = 0.f;
#pragma unroll
        for (int ih = 0; ih < 2; ++ih) {
#pragma unroll
            for (int it2 = 0; it2 < 4; ++it2) { const int itr = 4 * ih + it2; const u32x4 yy = *(const LAS u32x4*)(T + tl * 528 + (c4 + 4 * itr) * 16); const u32x4 z = ih == 0 ? zzA[it2] : zzB[it2];
                const float y0 = bflo(yy.x) * bflo(z.x), y1 = bfhi(yy.x) * bfhi(z.x), y2 = bflo(yy.y) * bflo(z.y), y3 = bfhi(yy.y) * bfhi(z.y);
                const float y4 = bflo(yy.z) * bflo(z.z), y5 = bfhi(yy.z) * bfhi(z.z), y6 = bflo(yy.w) * bflo(z.w), y7 = bfhi(yy.w) * bfhi(z.w);
                ssq += ((y0 * y0 + y1 * y1) + (y2 * y2 + y3 * y3)) + ((y4 * y4 + y5 * y5) + (y6 * y6 + y7 * y7));
                u32x4 o; o.x = pk2(y0, y1); o.y = pk2(y2, y3); o.z = pk2(y4, y5); o.w = pk2(y6, y7);
                *(u32x4*)(zrow + (c4 + 4 * itr) * 8) = o; }
        }
        ssq += __shfl_xor(ssq, 1); ssq += __shfl_xor(ssq, 2);
        if (c4 == 0) SSQ[(size_t)tok * 4 + g] = ssq;
    }
    __syncthreads();
}

__global__ void __launch_bounds__(512) fwd_megakernel(Params p) {
    extern __shared__ __attribute__((aligned(16))) unsigned char lds_raw[];
    LAS unsigned char* lds = (LAS unsigned char*)lds_raw;
    cg::grid_group grid = cg::this_grid();
    volatile LAS unsigned* xst = (volatile LAS unsigned*)(lds + LDS_WORK);
    if (threadIdx.x == 0) { xst[0] = 0u; xst[1] = 0u; xst[2] = 0u; xst[3] = 0u; }
    __syncthreads();
    (void)xcd_barrier_post((unsigned*)(p.ws + OFF_BAR), xst);
#define XBAR() do { XcdBarrier b_; b_.bar = (unsigned*)(p.ws + OFF_BAR); b_.x = xb_xcc_id(); b_.st = (volatile LAS unsigned*)(lds + LDS_WORK); xcd_barrier(b_); } while (0)
    pg8::StaticOrder so;
    const float* mod = (const float*)(p.ws + OFF_MOD);

#ifndef SKIP_P0
    phase0a(p, lds);
#endif
    if (p.out == nullptr) grid.sync();
    XBAR();
#ifndef SKIP_P1
    phase_norm_mod<0>(p);
#endif
#ifndef SKIP_P0
    {
        const bool defer = gridDim.x == 256;
        phase0b(p, lds, 0, defer ? 8 * 41 : (1 << 20), blockIdx.x, gridDim.x);
    }
#endif
    XBAR();
#ifndef SKIP_G1
    {
        pg8::Gemm g{(const bf16_t*)(p.ws + OFF_HB), (const bf16_t*)(p.ws + OFF_HB), (const bf16_t*)(p.ws + OFF_WIN), 1024, 1024, 16, 16, 1 << 20, 0, 0, nullptr};
        so.init(MT, NIN, gridDim.x, blockIdx.x);
        pg8::EpiInProj e{(bf16_t*)(p.ws + OFF_ZG), (bf16_t*)p.out, (bf16_t*)(p.ws + OFF_U), (bf16_t*)(p.ws + OFF_V), (float*)(p.ws + OFF_DT), (float*)(p.ws + OFF_LNP)};
        pg8::gemm_phase(lds, g, so, e);
    }
#endif
#ifndef SKIP_P0
    if (gridDim.x == 256) phase0b(p, lds, 8 * 41, 1 << 20, (int)blockIdx.x - 144, 112);
#endif
    XBAR();
#ifndef SKIP_P3
    phase3(p, lds);
#endif
    XBAR();
#ifndef SKIP_P4
    phase4(p);
#endif
    XBAR();
#ifndef SKIP_P5
    for (int it = blockIdx.x; it < 640; it += gridDim.x) p5_item(p, lds, it >> 2, it & 3);
    if (gridDim.x == 256 && blockIdx.x >= 128) for (int k = 0; k < 5; ++k) { const int it = 640 + (blockIdx.x - 128) * 5 + k; p3_cmlp_item(p, lds, it >> 3, it & 7); }
#endif
    XBAR();
#ifndef SKIP_G3
    {
        pg8::Gemm g{(const bf16_t*)(p.ws + OFF_ZG), (const bf16_t*)(p.ws + OFF_U), (const bf16_t*)(p.ws + OFF_WOUT), 1024, 2048, 32, 16, 1 << 20, 0, 0, (const float*)(p.ws + OFF_SSQ)};
        pg8::HybridOrder3 ho{(int)gridDim.x, (int)blockIdx.x, (size_t)(OFF_U - OFF_ZG)};
        pg8::EpiPartialQ3 e{mod + 2048, (const float*)(p.ws + OFF_SSQ), (bf16_t*)(p.ws + OFF_P3A), (bf16_t*)(p.ws + OFF_P3B)};
        pg8::gemm_phase(lds, g, ho, e);
    }
#endif
    XBAR();
#ifndef SKIP_P6
    phase_norm_mod<1>(p);
#endif
    XBAR();
#ifndef SKIP_G4
    {
        pg8::Gemm g{(const bf16_t*)(p.ws + OFF_HB), (const bf16_t*)(p.ws + OFF_HB), (const bf16_t*)(p.ws + OFF_WFF1), 1024, 1024, 16, 16, 1 << 20, 0, 0, nullptr};
        so.init(MT, 4096, gridDim.x, blockIdx.x);
        pg8::EpiRelu2 e{(bf16_t*)(p.ws + OFF_F)};
        pg8::gemm_phase(lds, g, so, e);
    }
#endif
    XBAR();
#ifndef SKIP_G5
    {
        pg8::Gemm g{(const bf16_t*)(p.ws + OFF_F), (const bf16_t*)(p.ws + OFF_F), (const bf16_t*)(p.ws + OFF_WFF2), 4096, 4096, 64, 1 << 20, 1 << 20, 0, 0, nullptr};
        pg8::HybridOrder5 ho{(int)gridDim.x, (int)blockIdx.x};
        pg8::EpiPartialQ e{mod + 5120, (bf16_t*)(p.ws + OFF_P5A), (bf16_t*)(p.ws + OFF_P5B)};
        pg8::gemm_phase(lds, g, ho, e);
    }
#endif
    XBAR();
#ifndef SKIP_P7
    phase_final_norm(p);
#endif
}

extern "C" void kernel_launch(void* const* d_in, const int* in_sizes, int n_in, void* d_out, int out_size, void* d_ws, size_t ws_size, hipStream_t stream) {
    static int grid_blocks = 0;
    if (grid_blocks == 0) {
        if (n_in != 24 || ws_size < WS_END) { fprintf(stderr, "kernel_launch: unexpected n_in %d / ws_size %zu (need %zu)\n", n_in, ws_size, (size_t)WS_END); grid_blocks = -1; return; }
        int dev = 0, cus = 0, per_cu = 0;
        hipGetDevice(&dev);
        hipDeviceGetAttribute(&cus, hipDeviceAttributeMultiprocessorCount, dev);
        if (hipFuncSetAttribute((const void*)fwd_megakernel, hipFuncAttributeMaxDynamicSharedMemorySize, LDS_BYTES) != hipSuccess) { fprintf(stderr, "kernel_launch: hipFuncSetAttribute failed\n"); grid_blocks = -1; return; }
        hipOccupancyMaxActiveBlocksPerMultiprocessor(&per_cu, (const void*)fwd_megakernel, 512, LDS_BYTES);
        if (per_cu < 1) per_cu = 1;
        grid_blocks = cus * per_cu;
        (void)hipGetLastError();
    }
    if (grid_blocks < 0) return;
    Params p{};
    for (int i = 0; i < 24; ++i) p.in[i] = (const float*)d_in[i];
    p.out = (float*)d_out; p.ws = (unsigned char*)d_ws;
    if (hipMemsetAsync((char*)d_ws + OFF_BAR, 0, 16384, stream) != hipSuccess) { fprintf(stderr, "kernel_launch: memset failed\n"); return; }
    void* args[] = {&p};
    hipError_t e = hipLaunchCooperativeKernel((const void*)fwd_megakernel, dim3(grid_blocks), dim3(512), args, LDS_BYTES, stream);
    if (e != hipSuccess) fprintf(stderr, "cooperative launch failed: %s (grid %d)\n", hipGetErrorString(e), grid_blocks);
}
```
